# Optimizing an MI355X kernel written in HIP

```python
import math
import jax
import jax.numpy as jnp
from jax import lax
import numpy as np

D_MODEL = 1024
BATCH = 2
SEQ = 8192
DEPTH = 2

GRID_W = 64
CTX_LEN = 256
HEAD_DIM = 64
BRANCH_WIDTH = D_MODEL // 2
N_BRANCH = 4
DIFF_HEADS = BRANCH_WIDTH // (2 * HEAD_DIM)
NA_HEADS = BRANCH_WIDTH // HEAD_DIM
NA_KH = 8
NA_KW = 16
GQA_Q_HEADS = BRANCH_WIDTH // HEAD_DIM
GQA_KV_HEADS = 2
SWA_Q_HEADS = BRANCH_WIDTH // HEAD_DIM
SWA_KV_HEADS = 2
SWA_WINDOW = 128
Q_BLOCK = 128
D_FF = ((8 * D_MODEL // 3 + 255) // 256) * 256
FFN_RES_WEIGHT = 0.5
ROPE_THETA = 10000.0
NORM_EPS = 1e-6
N_MOD = 9

kernel_name = "hybrid_gated_branch_dit_block"


def _segments():
    widths = [
        ("a_q", DIFF_HEADS * 2 * HEAD_DIM), ("a_k", DIFF_HEADS * 2 * HEAD_DIM), ("a_v", DIFF_HEADS * 2 * HEAD_DIM),
        ("b_q", NA_HEADS * HEAD_DIM), ("b_k", NA_HEADS * HEAD_DIM), ("b_v", NA_HEADS * HEAD_DIM),
        ("c_q", GQA_Q_HEADS * HEAD_DIM), ("c_k", GQA_KV_HEADS * HEAD_DIM), ("c_v", GQA_KV_HEADS * HEAD_DIM),
        ("d_q", SWA_Q_HEADS * HEAD_DIM), ("d_k", SWA_KV_HEADS * HEAD_DIM), ("d_v", SWA_KV_HEADS * HEAD_DIM),
    ] + [("gate%d" % i, D_MODEL) for i in range(N_BRANCH)]
    seg, off = {}, 0
    for name, w in widths:
        seg[name] = (off, off + w)
        off += w
    return seg, off


def rms_norm(x, g):
    xf = x.astype(jnp.float32)
    y = xf * lax.rsqrt(jnp.mean(jnp.square(xf), axis=-1, keepdims=True) + NORM_EPS)
    return (y * g.astype(jnp.float32)).astype(x.dtype)


def swiglu(u, wg, wu, wd):
    return (jax.nn.silu(u @ wg) * (u @ wu)) @ wd


def rope_2d_tables(n_tok):
    t = jnp.arange(n_tok, dtype=jnp.int32)
    row = (t // GRID_W).astype(jnp.float32)
    col = (t % GRID_W).astype(jnp.float32)
    n_freq = HEAD_DIM // 4
    inv_freq = ROPE_THETA ** (-jnp.arange(n_freq, dtype=jnp.float32) / n_freq)
    ang = jnp.stack([row[:, None] * inv_freq, col[:, None] * inv_freq], axis=1)
    return jnp.cos(ang), jnp.sin(ang)


def apply_rope_2d(x, cos, sin):
    xf = x.astype(jnp.float32).reshape(x.shape[:-1] + (2, 2, HEAD_DIM // 4))
    x1, x2 = xf[..., 0, :], xf[..., 1, :]
    out = jnp.stack([x1 * cos - x2 * sin, x2 * cos + x1 * sin], axis=-2)
    return out.reshape(x.shape).astype(x.dtype)


def _heads(t, n):
    b, s, _ = t.shape
    return t.reshape(b, s, n, -1).transpose(0, 2, 1, 3)


def _gqa_heads(t, n_kv):
    b, s, _ = t.shape
    return t.reshape(b, s, n_kv, -1, HEAD_DIM).transpose(0, 2, 3, 1, 4)


def _merge(t):
    b, h, s, d = t.shape
    return t.transpose(0, 2, 1, 3).reshape(b, s, h * d)


def _merge_gqa(t):
    b, n, g, s, d = t.shape
    return t.transpose(0, 3, 1, 2, 4).reshape(b, s, n * g * d)


def _diff_split(t):
    b, s, _ = t.shape
    t = t.reshape(b, s, DIFF_HEADS, 2, HEAD_DIM).transpose(3, 0, 2, 1, 4)
    return t[0], t[1]


def _to_blocks(t, axis):
    shp = t.shape
    t = t.reshape(shp[:axis] + (shp[axis] // Q_BLOCK, Q_BLOCK) + shp[axis + 1:])
    return jnp.moveaxis(t, axis, 0)


def _from_blocks(t, axis):
    t = jnp.moveaxis(t, 0, axis)
    shp = t.shape
    return t.reshape(shp[:axis] + (shp[axis] * shp[axis + 1],) + shp[axis + 2:])


def _diff_attend(q1, q2, k1, k2, v, lam):
    scale = HEAD_DIM ** -0.5
    s1 = jnp.einsum('bhqd,bhkd->bhqk', q1, k1).astype(jnp.float32) * scale
    s2 = jnp.einsum('bhqd,bhkd->bhqk', q2, k2).astype(jnp.float32) * scale
    a = jax.nn.softmax(s1, axis=-1) - lam * jax.nn.softmax(s2, axis=-1)
    return jnp.einsum('bhqk,bhkd->bhqd', a.astype(v.dtype), v)


def _mha(q, k, v):
    s = jnp.einsum('bhqd,bhkd->bhqk', q, k).astype(jnp.float32) * HEAD_DIM ** -0.5
    p = jax.nn.softmax(s, axis=-1).astype(v.dtype)
    return jnp.einsum('bhqk,bhkd->bhqd', p, v)


def _gqa_attend(q, k, v, sink_ng=None):
    s = jnp.einsum('bngqd,bnkd->bngqk', q, k).astype(jnp.float32) * HEAD_DIM ** -0.5
    if sink_ng is None:
        p = jax.nn.softmax(s, axis=-1)
    else:
        sk = jnp.broadcast_to(sink_ng[None, :, :, None, None], s.shape[:-1] + (1,))
        p = jax.nn.softmax(jnp.concatenate([s, sk], axis=-1), axis=-1)[..., :-1]
    return jnp.einsum('bngqk,bnkd->bngqd', p.astype(v.dtype), v)


def neighbourhood_attention(q, k, v, k_ctx, v_ctx, rel_bias):
    b, h, s, d = q.shape
    rows = s // GRID_W
    kh, kw = min(NA_KH, rows), min(NA_KW, GRID_W)
    scale = d ** -0.5
    qg = q.reshape(b, h, rows, GRID_W, d)
    kg = k.reshape(b, h, rows, GRID_W, d)
    vg = v.reshape(b, h, rows, GRID_W, d)
    r_idx = jnp.arange(rows, dtype=jnp.int32)
    row_start = jnp.clip(r_idx - kh // 2, 0, rows - kh)
    cq = jnp.arange(GRID_W, dtype=jnp.int32)
    col_idx = jnp.clip(cq - kw // 2, 0, GRID_W - kw)[:, None] + jnp.arange(kw, dtype=jnp.int32)
    col_bias_idx = col_idx - cq[:, None] + (NA_KW - 1)

    def one_row(args):
        q_row, r, r0 = args
        k_slab = lax.dynamic_slice_in_dim(kg, r0, kh, axis=2)
        v_slab = lax.dynamic_slice_in_dim(vg, r0, kh, axis=2)
        k_win = k_slab[:, :, :, col_idx]
        v_win = v_slab[:, :, :, col_idx]
        s_loc = jnp.einsum('bhqd,bhrqkd->bhqrk', q_row, k_win).astype(jnp.float32) * scale
        row_bias_idx = r0 + jnp.arange(kh, dtype=jnp.int32) - r + (NA_KH - 1)
        bias = rel_bias[:, row_bias_idx[None, :, None], col_bias_idx[:, None, :]]
        s_loc = (s_loc + bias.astype(jnp.float32)[None]).reshape(b, h, GRID_W, kh * kw)
        s_ctx = jnp.einsum('bhqd,bhcd->bhqc', q_row, k_ctx).astype(jnp.float32) * scale
        p = jax.nn.softmax(jnp.concatenate([s_loc, s_ctx], axis=-1), axis=-1).astype(v.dtype)
        p_loc = p[..., :kh * kw].reshape(b, h, GRID_W, kh, kw)
        return (jnp.einsum('bhqrk,bhrqkd->bhqd', p_loc, v_win)
                + jnp.einsum('bhqc,bhcd->bhqd', p[..., kh * kw:], v_ctx))

    out = lax.map(one_row, (jnp.moveaxis(qg, 2, 0), r_idx, row_start))
    return jnp.moveaxis(out, 0, 2).reshape(b, h, s, d)


def sliding_window_attention(q, k, v, k_ctx, v_ctx, sink_ng):
    b, n, g, s, d = q.shape
    nb = s // Q_BLOCK
    scale = d ** -0.5
    qb = q.reshape(b, n, g, nb, Q_BLOCK, d)

    def band(t):
        tp = jnp.pad(t.reshape(b, n, nb, Q_BLOCK, d), ((0, 0), (0, 0), (1, 1), (0, 0), (0, 0)))
        return jnp.concatenate([tp[:, :, :-2], tp[:, :, 1:-1], tp[:, :, 2:]], axis=3)

    kb, vb = band(k), band(v)
    qi = jnp.arange(Q_BLOCK, dtype=jnp.int32)
    kj = jnp.arange(3 * Q_BLOCK, dtype=jnp.int32)
    in_window = jnp.abs(kj[None, :] - Q_BLOCK - qi[:, None]) <= SWA_WINDOW
    kpos = (jnp.arange(nb, dtype=jnp.int32)[:, None] - 1) * Q_BLOCK + kj[None, :]
    mask = in_window[None] & ((kpos >= 0) & (kpos < s))[:, None, :]
    s_band = jnp.einsum('bngxqd,bnxkd->bngxqk', qb, kb).astype(jnp.float32) * scale
    s_band = jnp.where(mask, s_band, -jnp.inf)
    s_ctx = jnp.einsum('bngxqd,bncd->bngxqc', qb, k_ctx).astype(jnp.float32) * scale
    s_sink = jnp.broadcast_to(sink_ng[None, :, :, None, None, None], s_ctx.shape[:-1] + (1,))
    p = jax.nn.softmax(jnp.concatenate([s_band, s_ctx, s_sink], axis=-1), axis=-1).astype(v.dtype)
    nk, nc = 3 * Q_BLOCK, k_ctx.shape[2]
    o = (jnp.einsum('bngxqk,bnxkd->bngxqd', p[..., :nk], vb)
         + jnp.einsum('bngxqc,bncd->bngxqd', p[..., nk:nk + nc], v_ctx))
    return o.reshape(b, n, g, s, d)


def token_mixer(u_x, u_c, w_in, w_branch, w_out, diff_lambda, diff_subln, na_bias, qk_gain, sink,
                lam_init, cos, sin, need_ctx):
    seg, _ = _segments()

    def proj(u, name):
        a, bnd = seg[name]
        return u @ w_in[:, a:bnd]

    ys_x, ys_c = [], []

    dl = diff_lambda.astype(jnp.float32)
    lam = jnp.exp(jnp.sum(dl[0] * dl[1])) - jnp.exp(jnp.sum(dl[2] * dl[3])) + lam_init
    q1, q2 = _diff_split(proj(u_x, 'a_q'))
    k1, k2 = _diff_split(proj(u_x, 'a_k'))
    k1c, k2c = _diff_split(proj(u_c, 'a_k'))
    vac = _heads(proj(u_c, 'a_v'), DIFF_HEADS)
    q1, q2 = apply_rope_2d(q1, cos, sin), apply_rope_2d(q2, cos, sin)
    k1_all = jnp.concatenate([apply_rope_2d(k1, cos, sin), k1c], axis=2)
    k2_all = jnp.concatenate([apply_rope_2d(k2, cos, sin), k2c], axis=2)
    va_all = jnp.concatenate([_heads(proj(u_x, 'a_v'), DIFF_HEADS), vac], axis=2)
    o = lax.map(lambda qq: _diff_attend(qq[0], qq[1], k1_all, k2_all, va_all, lam),
                (_to_blocks(q1, 2), _to_blocks(q2, 2)))
    ys_x.append(_merge(rms_norm(_from_blocks(o, 2), diff_subln) * (1.0 - lam_init)))
    if need_ctx:
        q1c, q2c = _diff_split(proj(u_c, 'a_q'))
        oc = _diff_attend(q1c, q2c, k1c, k2c, vac, lam)
        ys_c.append(_merge(rms_norm(oc, diff_subln) * (1.0 - lam_init)))

    kbc = _heads(proj(u_c, 'b_k'), NA_HEADS)
    vbc = _heads(proj(u_c, 'b_v'), NA_HEADS)
    ob = neighbourhood_attention(_heads(proj(u_x, 'b_q'), NA_HEADS), _heads(proj(u_x, 'b_k'), NA_HEADS),
                                 _heads(proj(u_x, 'b_v'), NA_HEADS), kbc, vbc, na_bias)
    ys_x.append(_merge(ob))
    if need_ctx:
        ys_c.append(_merge(_mha(_heads(proj(u_c, 'b_q'), NA_HEADS), kbc, vbc)))

    qc_ = apply_rope_2d(rms_norm(_gqa_heads(proj(u_x, 'c_q'), GQA_KV_HEADS), qk_gain[0]), cos, sin)
    kc_ = apply_rope_2d(rms_norm(_heads(proj(u_x, 'c_k'), GQA_KV_HEADS), qk_gain[1]), cos, sin)
    kcc = rms_norm(_heads(proj(u_c, 'c_k'), GQA_KV_HEADS), qk_gain[1])
    vcc = _heads(proj(u_c, 'c_v'), GQA_KV_HEADS)
    kc_all = jnp.concatenate([kc_, kcc], axis=2)
    vc_all = jnp.concatenate([_heads(proj(u_x, 'c_v'), GQA_KV_HEADS), vcc], axis=2)
    oc_ = lax.map(lambda qb: _gqa_attend(qb, kc_all, vc_all), _to_blocks(qc_, 3))
    ys_x.append(_merge_gqa(_from_blocks(oc_, 3)))
    if need_ctx:
        qcc = rms_norm(_gqa_heads(proj(u_c, 'c_q'), GQA_KV_HEADS), qk_gain[0])
        ys_c.append(_merge_gqa(_gqa_attend(qcc, kcc, vcc)))

    sink_ng = sink.astype(jnp.float32).reshape(SWA_KV_HEADS, SWA_Q_HEADS // SWA_KV_HEADS)
    kdc = _heads(proj(u_c, 'd_k'), SWA_KV_HEADS)
    vdc = _heads(proj(u_c, 'd_v'), SWA_KV_HEADS)
    od = sliding_window_attention(
        apply_rope_2d(_gqa_heads(proj(u_x, 'd_q'), SWA_KV_HEADS), cos, sin),
        apply_rope_2d(_heads(proj(u_x, 'd_k'), SWA_KV_HEADS), cos, sin),
        _heads(proj(u_x, 'd_v'), SWA_KV_HEADS), kdc, vdc, sink_ng)
    ys_x.append(_merge_gqa(od))
    if need_ctx:
        ys_c.append(_merge_gqa(_gqa_attend(_gqa_heads(proj(u_c, 'd_q'), SWA_KV_HEADS), kdc, vdc, sink_ng)))

    def merge_branches(u, ys):
        acc = jax.nn.sigmoid(proj(u, 'gate0')) * (ys[0] @ w_branch[0])
        for i in range(1, N_BRANCH):
            acc = acc + jax.nn.sigmoid(proj(u, 'gate%d' % i)) * (ys[i] @ w_branch[i])
        return acc @ w_out

    y_x = merge_branches(u_x, ys_x)
    y_c = merge_branches(u_c, ys_c) if need_ctx else None
    return y_x, y_c


def _ffn_sublayer(h, mod, k, g_pre, g_post, wg, wu, wd):
    u = rms_norm(h, g_pre) * (1.0 + mod[:, :, 3 * k + 1]) + mod[:, :, 3 * k]
    return h + FFN_RES_WEIGHT * mod[:, :, 3 * k + 2] * rms_norm(swiglu(u, wg, wu, wd), g_post)


def setup_inputs(seed: int = 0) -> dict:
    key = jax.random.key(seed)
    ks = jax.random.split(key, 20)
    _, in_width = _segments()
    f32 = jnp.float32

    def w(k, shape, fan_in, mult=1.0):
        return jax.random.normal(k, shape, f32) * (mult * fan_in ** -0.5)

    def gain(k, shape):
        return 1.0 + 0.05 * jax.random.normal(k, shape, f32)

    return {
        "x": jax.random.normal(ks[0], (BATCH, SEQ, D_MODEL), f32),
        "c": jax.random.normal(ks[1], (BATCH, D_MODEL), f32),
        "ctx": jax.random.normal(ks[2], (BATCH, CTX_LEN, D_MODEL), f32),
        "c_ctx": jax.random.normal(ks[3], (D_MODEL,), f32),
        "w_mod": w(ks[4], (DEPTH, D_MODEL, N_MOD * D_MODEL), D_MODEL, 0.5),
        "b_mod": 0.02 * jax.random.normal(ks[5], (DEPTH, N_MOD * D_MODEL), f32),
        "norm_gain": gain(ks[6], (DEPTH, 6, D_MODEL)),
        "ffn_w_gate": w(ks[7], (DEPTH, 2, D_MODEL, D_FF), D_MODEL),
        "ffn_w_up": w(ks[8], (DEPTH, 2, D_MODEL, D_FF), D_MODEL),
        "ffn_w_down": w(ks[9], (DEPTH, 2, D_FF, D_MODEL), D_FF),
        "w_in": w(ks[10], (DEPTH, D_MODEL, in_width), D_MODEL),
        "w_branch": w(ks[11], (DEPTH, N_BRANCH, BRANCH_WIDTH, D_MODEL), BRANCH_WIDTH),
        "w_out": w(ks[12], (DEPTH, D_MODEL, D_MODEL), D_MODEL),
        "diff_lambda": 0.1 * jax.random.normal(ks[13], (DEPTH, 4, HEAD_DIM), f32),
        "diff_subln": gain(ks[14], (DEPTH, 2 * HEAD_DIM)),
        "na_bias": 0.1 * jax.random.normal(ks[15], (DEPTH, NA_HEADS, 2 * NA_KH - 1, 2 * NA_KW - 1), f32),
        "qk_norm": gain(ks[16], (DEPTH, 2, HEAD_DIM)),
        "sink": 0.5 * jax.random.normal(ks[17], (DEPTH, SWA_Q_HEADS), f32),
    }


def reference(x, c, ctx, c_ctx, w_mod, b_mod, norm_gain, ffn_w_gate, ffn_w_up, ffn_w_down, w_in, w_branch,
              w_out, diff_lambda, diff_subln, na_bias, qk_norm, sink):
    bsz, n_tok, d = x.shape
    cos, sin = rope_2d_tables(n_tok)
    h_x, h_c = x, ctx
    sc, scc = jax.nn.silu(c), jax.nn.silu(c_ctx)
    for l in range(DEPTH):
        last = l == DEPTH - 1
        lam_init = 0.8 - 0.6 * math.exp(-0.3 * l)
        mod_x = (sc @ w_mod[l] + b_mod[l]).reshape(bsz, 1, N_MOD, d)
        mod_c = (scc @ w_mod[l] + b_mod[l]).reshape(1, 1, N_MOD, d)
        g = norm_gain[l]
        h_x = _ffn_sublayer(h_x, mod_x, 0, g[0], g[1], ffn_w_gate[l, 0], ffn_w_up[l, 0], ffn_w_down[l, 0])
        h_c = _ffn_sublayer(h_c, mod_c, 0, g[0], g[1], ffn_w_gate[l, 0], ffn_w_up[l, 0], ffn_w_down[l, 0])
        u_x = rms_norm(h_x, g[2]) * (1.0 + mod_x[:, :, 4]) + mod_x[:, :, 3]
        u_c = rms_norm(h_c, g[2]) * (1.0 + mod_c[:, :, 4]) + mod_c[:, :, 3]
        y_x, y_c = token_mixer(u_x, u_c, w_in[l], w_branch[l], w_out[l], diff_lambda[l], diff_subln[l],
                               na_bias[l], qk_norm[l], sink[l], lam_init, cos, sin, not last)
        h_x = h_x + mod_x[:, :, 5] * rms_norm(y_x, g[3])
        h_x = _ffn_sublayer(h_x, mod_x, 2, g[4], g[5], ffn_w_gate[l, 1], ffn_w_up[l, 1], ffn_w_down[l, 1])
        if not last:
            h_c = h_c + mod_c[:, :, 5] * rms_norm(y_c, g[3])
            h_c = _ffn_sublayer(h_c, mod_c, 2, g[4], g[5], ffn_w_gate[l, 1], ffn_w_up[l, 1], ffn_w_down[l, 1])
    return h_x
```

```cpp
#include <hip/hip_runtime.h>
#include <hip/hip_cooperative_groups.h>
#include <cstdio>
namespace cg = cooperative_groups;

typedef unsigned short u16;
typedef short bf16x8 __attribute__((ext_vector_type(8)));
typedef short s16x4 __attribute__((ext_vector_type(4)));
typedef float f32x16 __attribute__((ext_vector_type(16)));
typedef float f32x2 __attribute__((ext_vector_type(2)));
typedef __bf16 bf16x2v __attribute__((ext_vector_type(2)));
typedef unsigned u32x4 __attribute__((ext_vector_type(4)));
typedef unsigned u32x2 __attribute__((ext_vector_type(2)));

#define DI __device__ __forceinline__

#ifndef MK_MULTI
#define MK_MULTI 0
#endif
#define REP_GEMM 1
#define REP_ATT 1
#define REP_SYNC 1
#define REP_INIT 1
#define REP_ROW0 1

constexpr int ML = 16384;
constexpr int MT = 16896;
constexpr int DFF = 2816;
constexpr int NQKV = 4608;
constexpr int NGATE = 4096;
constexpr float LOG2E = 1.4426950408889634f;
constexpr float EPSN = 1e-6f;
constexpr int NPHASE = 26;

constexpr size_t SZ_WGU = (size_t)5632 * 1024 * 2;
constexpr size_t SZ_WD = (size_t)1024 * 2816 * 2;
constexpr size_t OFF_WGU1 = 0;
constexpr size_t OFF_WD1 = OFF_WGU1 + SZ_WGU;
constexpr size_t OFF_WGU2 = OFF_WD1 + SZ_WD;
constexpr size_t OFF_WD2 = OFF_WGU2 + SZ_WGU;
constexpr size_t OFF_WIN = OFF_WD2 + SZ_WD;
constexpr size_t OFF_WB = OFF_WIN + (size_t)8704 * 1024 * 2;
constexpr size_t OFF_WOUT = OFF_WB + (size_t)4 * 1024 * 512 * 2;
constexpr size_t OFF_U = OFF_WOUT + (size_t)1024 * 1024 * 2;
constexpr size_t OFF_T = OFF_U + (size_t)MT * 1024 * 2;
constexpr size_t OFF_P = OFF_T + (size_t)MT * 1024 * 4;
constexpr size_t OFF_HC = OFF_P + (size_t)MT * NQKV * 2;
constexpr size_t OFF_MOD = OFF_HC + (size_t)512 * 1024 * 4;
constexpr size_t OFF_MISC = OFF_MOD + (size_t)2 * 3 * 9216 * 4;
constexpr size_t OFF_BAR = OFF_MISC + 4096;
constexpr size_t OFF_STASH = OFF_BAR + 16384;

struct Params {
  const float *x, *c, *ctx, *c_ctx, *w_mod, *b_mod, *norm_gain, *wg, *wu, *wd, *w_in, *w_branch, *w_out;
  const float *diff_lambda, *diff_subln, *na_bias, *qk_norm, *sink;
  float* out;
  char* ws;
  int phase_lo, phase_hi, coop, pad;
};

DI unsigned pack2(float a, float b) {
  f32x2 v = {a, b};
  return __builtin_bit_cast(unsigned, __builtin_convertvector(v, bf16x2v));
}
DI u16 f2bf(float a) { return (u16)(pack2(a, 0.f) & 0xffffu); }
DI float bf2f(u16 v) { return __uint_as_float(((unsigned)v) << 16); }
DI f32x16 mfma32(bf16x8 a, bf16x8 b, f32x16 c) { return __builtin_amdgcn_mfma_f32_32x32x16_bf16(a, b, c, 0, 0, 0); }
DI float fexp2(float x) { return __builtin_amdgcn_exp2f(x); }
DI float wave_sum(float v) {
#pragma unroll
  for (int o = 32; o > 0; o >>= 1) v += __shfl_xor(v, o);
  return v;
}
DI int opaque_tid() { int t = threadIdx.x; asm volatile("" : "+v"(t)); return t; }
DI char* opaque_ws(char* q) { size_t z = 0; asm volatile("" : "+s"(z)); return q + z; }
DI int clampi(int v, int lo, int hi) { return v < lo ? lo : (v > hi ? hi : v); }
DI int crow(int i, int h) { return (i & 3) + 8 * (i >> 2) + 4 * h; }

DI void modgemv_item(const Params& p, int it, float* sm) {
  const int l = it / 144, n0 = (it % 144) * 64;
  float* s_in = sm;
  float* red = sm + 3072;
  const int tid = opaque_tid();
  for (int i = tid; i < 3072; i += 512) {
    const int v = i >> 10, k = i & 1023;
    const float xv = v < 2 ? p.c[v * 1024 + k] : p.c_ctx[k];
    s_in[i] = xv / (1.f + __expf(-xv));
  }
  __syncthreads();
  const int kg = tid >> 4, c4 = tid & 15;
  const float* w = p.w_mod + (size_t)l * 1024 * 9216 + n0 + c4 * 4;
  float a0x = 0, a0y = 0, a0z = 0, a0w = 0, a1x = 0, a1y = 0, a1z = 0, a1w = 0, a2x = 0, a2y = 0, a2z = 0, a2w = 0;
#pragma unroll 8
  for (int kk = 0; kk < 32; ++kk) {
    const int k = kg * 32 + kk;
    const float4 wv = *(const float4*)(w + (size_t)k * 9216);
    const float s0 = s_in[k], s1 = s_in[1024 + k], s2 = s_in[2048 + k];
    a0x += s0 * wv.x; a0y += s0 * wv.y; a0z += s0 * wv.z; a0w += s0 * wv.w;
    a1x += s1 * wv.x; a1y += s1 * wv.y; a1z += s1 * wv.z; a1w += s1 * wv.w;
    a2x += s2 * wv.x; a2y += s2 * wv.y; a2z += s2 * wv.z; a2w += s2 * wv.w;
  }
  float* r0 = red + (kg * 3 + 0) * 64 + c4 * 4;
  r0[0] = a0x; r0[1] = a0y; r0[2] = a0z; r0[3] = a0w;
  float* r1 = red + (kg * 3 + 1) * 64 + c4 * 4;
  r1[0] = a1x; r1[1] = a1y; r1[2] = a1z; r1[3] = a1w;
  float* r2 = red + (kg * 3 + 2) * 64 + c4 * 4;
  r2[0] = a2x; r2[1] = a2y; r2[2] = a2z; r2[3] = a2w;
  __syncthreads();
  if (tid < 192) {
    const int v = tid >> 6, cc = tid & 63;
    float s = 0.f;
#pragma unroll
    for (int g = 0; g < 32; ++g) s += red[(g * 3 + v) * 64 + cc];
    s += p.b_mod[l * 9216 + n0 + cc];
    float* mod = (float*)(p.ws + OFF_MOD);
    mod[(l * 3 + v) * 9216 + n0 + cc] = s;
  }
  __syncthreads();
}

DI int qk_perm(int d) { return ((d >> 4) & 1) * 32 + (d >> 5) * 16 + (d & 15); }
DI int mapcol(int mode, int n) {
  if (mode == 0) return n;
  if (mode == 1) return (n >> 5) * 64 + (n & 31);
  if (mode == 2) return (n >> 5) * 64 + 32 + (n & 31);
  const int unit = n >> 6;
  const bool qk = (unit < 16) || (unit >= 24 && unit < 40) || (unit >= 48 && unit < 58) || (unit >= 60 && unit < 70);
  return qk ? ((n & ~63) + qk_perm(n & 63)) : n;
}

struct ConvJob { const float* src; u16* dst; int N, ldd, mode, k0, n0; };
DI ConvJob convert_job(const Params& p, int l, int j) {
  ConvJob c; int K;
  if (j < 4224) {
    const int sub = j / 2112; int jj = j - sub * 2112;
    const int which = jj / 704; jj -= which * 704;
    const size_t lw = (size_t)(l * 2 + sub) * 1024 * 2816;
    if (which == 0) { c.src = p.wg + lw; K = 1024; c.N = 2816; c.mode = 1; c.dst = (u16*)(p.ws + (sub ? OFF_WGU2 : OFF_WGU1)); }
    else if (which == 1) { c.src = p.wu + lw; K = 1024; c.N = 2816; c.mode = 2; c.dst = (u16*)(p.ws + (sub ? OFF_WGU2 : OFF_WGU1)); }
    else { c.src = p.wd + lw; K = 2816; c.N = 1024; c.mode = 0; c.dst = (u16*)(p.ws + (sub ? OFF_WD2 : OFF_WD1)); }
    j = jj;
  } else if (j < 6400) {
    j -= 4224; c.src = p.w_in + (size_t)l * 1024 * 8704; K = 1024; c.N = 8704; c.mode = 3; c.dst = (u16*)(p.ws + OFF_WIN);
  } else if (j < 6912) {
    j -= 6400; const int i = j >> 7; j &= 127;
    c.src = p.w_branch + (size_t)(l * 4 + i) * 512 * 1024; K = 512; c.N = 1024; c.mode = 0; c.dst = (u16*)(p.ws + OFF_WB) + (size_t)i * 1024 * 512;
  } else {
    j -= 6912; c.src = p.w_out + (size_t)l * 1024 * 1024; K = 1024; c.N = 1024; c.mode = 0; c.dst = (u16*)(p.ws + OFF_WOUT);
  }
  const int nk = K >> 6;
  c.k0 = (j % nk) * 64; c.n0 = (j / nk) * 64; c.ldd = K;
  return c;
}

DI void convert_pair(const Params& p, int l, int jbase, float* sm0) {
  const int tid512 = opaque_tid();
  const int half = tid512 >> 8, tid = tid512 & 255;
  float* sm = sm0 + half * 8320;
  const int j0 = jbase + 2 * half, j1 = jbase + 2 * half + 1;
  const int r = tid >> 4, c4 = tid & 15;
  const bool two = j1 >= 0;
  const ConvJob a = convert_job(p, l, j0);
  const ConvJob b = convert_job(p, l, two ? j1 : j0);
  float4 va[4], vb[4];
#pragma unroll
  for (int i = 0; i < 4; ++i) va[i] = *(const float4*)(a.src + (size_t)(a.k0 + r + 16 * i) * a.N + a.n0 + c4 * 4);
  if (two) {
#pragma unroll
    for (int i = 0; i < 4; ++i) vb[i] = *(const float4*)(b.src + (size_t)(b.k0 + r + 16 * i) * b.N + b.n0 + c4 * 4);
  }
#pragma unroll
  for (int i = 0; i < 4; ++i) {
    float* d = sm + (r + 16 * i) * 65 + c4 * 4;
    d[0] = va[i].x; d[1] = va[i].y; d[2] = va[i].z; d[3] = va[i].w;
  }
  if (two) {
#pragma unroll
    for (int i = 0; i < 4; ++i) {
      float* d = sm + 4160 + (r + 16 * i) * 65 + c4 * 4;
      d[0] = vb[i].x; d[1] = vb[i].y; d[2] = vb[i].z; d[3] = vb[i].w;
    }
  }
  __syncthreads();
#pragma unroll
  for (int t = 0; t < 2; ++t) {
    if (t == 1 && !two) break;
    const ConvJob& c = t ? b : a;
    const float* st = sm + t * 4160;
#pragma unroll
    for (int i = 0; i < 2; ++i) {
      const int n = (tid >> 3) + 32 * i, k8 = tid & 7;
      u32x4 o;
#pragma unroll
      for (int j = 0; j < 4; ++j) o[j] = pack2(st[(k8 * 8 + 2 * j) * 65 + n], st[(k8 * 8 + 2 * j + 1) * 65 + n]);
      const int nn = mapcol(c.mode, c.n0 + n);
      *(u32x4*)(c.dst + (size_t)nn * c.ldd + c.k0 + k8 * 8) = o;
    }
  }
  __syncthreads();
}

DI void phase_init(const Params& p, char* smem) {
  if (blockIdx.x == 0 && threadIdx.x == 0) {
    float* lam = (float*)(p.ws + OFF_MISC + 64);
    for (int l = 0; l < 2; ++l) {
      const float* dl = p.diff_lambda + l * 256;
      float s01 = 0.f, s23 = 0.f;
      for (int i = 0; i < 64; ++i) { s01 += dl[i] * dl[64 + i]; s23 += dl[128 + i] * dl[192 + i]; }
      const float lam_init = 0.8f - 0.6f * expf(-0.3f * (float)l);
      lam[l] = expf(s01) - expf(s23) + lam_init;
    }
  }
  for (int it = blockIdx.x; it < 288; it += gridDim.x) modgemv_item(p, it, (float*)smem);
  for (int it = blockIdx.x; it < 1792; it += gridDim.x) convert_pair(p, 0, 4 * it, (float*)smem);
}

DI void rowpass(const Params& p, int l, int mode) {
  const int tid = opaque_tid();
  const int lane = tid & 63;
  const int wv = blockIdx.x * 8 + (tid >> 6), nw = gridDim.x * 8;
  const float* MOD = (const float*)(p.ws + OFF_MOD);
  const u16* T = (const u16*)(p.ws + OFF_T);
  u16* U = (u16*)(p.ws + OFF_U);
  float* HC = (float*)(p.ws + OFF_HC);
  int gpost = 0, gidx = 0, gpre = 0, sh = 0; float coef = 0.f;
  if (mode == 0) { gpre = 0; sh = 0; }
  else if (mode == 1) { gpost = 1; gidx = 2; coef = 0.5f; gpre = 2; sh = 3; }
  else if (mode == 2) { gpost = 3; gidx = 5; coef = 1.0f; gpre = 4; sh = 6; }
  else { gpost = 5; gidx = 8; coef = 0.5f; gpre = 0; sh = 0; }
  const int ln = (mode == 3) ? l + 1 : l;
  const bool has_u = ln < 2;
  const int nrows = (l == 1 && mode >= 2) ? ML : MT;
  for (int row = wv; row < nrows; row += nw) {
    const bool lat = row < ML;
    const int vi = lat ? (row >> 13) : 2;
    float* hp = lat ? p.out + (size_t)row * 1024 : HC + (size_t)(row - ML) * 1024;
    float4 h[4];
    if (mode == 0) {
      const float* sp = lat ? p.x + (size_t)row * 1024 : p.ctx + (size_t)(row - ML) * 1024;
#pragma unroll
      for (int i = 0; i < 4; ++i) h[i] = *(const float4*)(sp + 4 * lane + 256 * i);
    } else {
      float4 t[4];
      const u16* tp = T + (size_t)row * 1024;
      const float* hsrc = (l == 0 && mode == 1) ? (lat ? p.x + (size_t)row * 1024 : p.ctx + (size_t)(row - ML) * 1024) : (const float*)hp;
      float ss = 0.f;
#pragma unroll
      for (int i = 0; i < 4; ++i) {
        h[i] = *(const float4*)(hsrc + 4 * lane + 256 * i);
        const u32x2 tv = *(const u32x2*)(tp + 4 * lane + 256 * i);
        t[i] = make_float4(__uint_as_float(tv[0] << 16), __uint_as_float(tv[0] & 0xffff0000u),
                           __uint_as_float(tv[1] << 16), __uint_as_float(tv[1] & 0xffff0000u));
        ss += t[i].x * t[i].x + t[i].y * t[i].y + t[i].z * t[i].z + t[i].w * t[i].w;
      }
      ss = wave_sum(ss);
      const float rstd = rsqrtf(ss * (1.f / 1024.f) + EPSN) * coef;
      const float* gate = MOD + (size_t)(l * 3 + vi) * 9216 + gidx * 1024;
      const float* gp = p.norm_gain + (size_t)(l * 6 + gpost) * 1024;
#pragma unroll
      for (int i = 0; i < 4; ++i) {
        const float4 ga = *(const float4*)(gate + 4 * lane + 256 * i);
        const float4 gg = *(const float4*)(gp + 4 * lane + 256 * i);
        h[i].x += ga.x * (t[i].x * rstd * gg.x);
        h[i].y += ga.y * (t[i].y * rstd * gg.y);
        h[i].z += ga.z * (t[i].z * rstd * gg.z);
        h[i].w += ga.w * (t[i].w * rstd * gg.w);
        *(float4*)(hp + 4 * lane + 256 * i) = h[i];
      }
    }
    if (has_u) {
      float ss = 0.f;
#pragma unroll
      for (int i = 0; i < 4; ++i) ss += h[i].x * h[i].x + h[i].y * h[i].y + h[i].z * h[i].z + h[i].w * h[i].w;
      ss = wave_sum(ss);
      const float rstd = rsqrtf(ss * (1.f / 1024.f) + EPSN);
      const float* modn = MOD + (size_t)(ln * 3 + vi) * 9216;
      const float* gq = p.norm_gain + (size_t)(ln * 6 + gpre) * 1024;
#pragma unroll
      for (int i = 0; i < 4; ++i) {
        const int cidx = 4 * lane + 256 * i;
        const float4 gg = *(const float4*)(gq + cidx);
        const float4 sf = *(const float4*)(modn + sh * 1024 + cidx);
        const float4 sc = *(const float4*)(modn + (sh + 1) * 1024 + cidx);
        const float u0 = h[i].x * rstd * gg.x * (1.f + sc.x) + sf.x;
        const float u1 = h[i].y * rstd * gg.y * (1.f + sc.y) + sf.y;
        const float u2 = h[i].z * rstd * gg.z * (1.f + sc.z) + sf.z;
        const float u3 = h[i].w * rstd * gg.w * (1.f + sc.w) + sf.w;
        u32x2 o = {pack2(u0, u1), pack2(u2, u3)};
        *(u32x2*)(U + (size_t)row * 1024 + cidx) = o;
      }
    }
  }
}

#define LAS __attribute__((address_space(3)))
#define GLDS_SO(base_, voff_, l_) { const unsigned la_ = __builtin_amdgcn_readfirstlane((unsigned)(size_t)((LAS char*)(l_))); unsigned keep_; \
    asm volatile("s_mov_b32 %0, m0\n\ts_mov_b32 m0, %3\n\ts_nop 0\n\tglobal_load_lds_dwordx4 %1, %2\n\ts_mov_b32 m0, %0" \
                 : "=&s"(keep_) : "v"(voff_), "s"(base_), "s"(la_) : "memory"); }
DI void glds16(const void* g, char* l) {
  const unsigned la = __builtin_amdgcn_readfirstlane((unsigned)(size_t)((LAS char*)l));
  unsigned keep;
  asm volatile("s_mov_b32 %0, m0\n\ts_mov_b32 m0, %2\n\ts_nop 0\n\tglobal_load_lds_dwordx4 %1, off\n\ts_mov_b32 m0, %0"
               : "=&s"(keep) : "v"(g), "s"(la) : "memory");
}

template <int NBW, bool TR = false>
DI void gemm_mainloop(const u16* __restrict__ A, int lda, const u16* __restrict__ BT, int ldb, int K,
                      f32x16 (&acc)[4][NBW], char* smem, const int tid) {
  const int lane = tid & 63, w = tid >> 6;
  const int wm = w >> 2, wn = w & 3, h = lane >> 5, r31 = lane & 31;
  constexpr int BST = 16384 * NBW;
  char* sA = smem;
  char* sB = smem + 65536;
  const int lr = tid >> 3;
  const int lc = (tid & 7) ^ ((tid >> 4) & 7);
  const u16* ga = A + (size_t)lr * lda + lc * 8;
  const int lrb = TR ? ((lr & ~31) + 16 * ((lr >> 2) & 1) + (lr & 3) + 4 * ((lr & 31) >> 3)) : lr;
  const u16* gb = BT + (size_t)lrb * ldb + lc * 8;
  char* wA = sA + tid * 16;
  char* wB = sB + tid * 16;
  const int sx = (r31 >> 1) & 7;
  const int aoff = (wm * 128 + r31) * 128;
  const int boff = (wn * 32 * NBW + r31) * 128;
#pragma unroll
  for (int i = 0; i < 4; ++i) glds16(ga + (size_t)(64 * i) * lda, wA + i * 8192);
#pragma unroll
  for (int i = 0; i < 2 * NBW; ++i) glds16(gb + (size_t)(64 * i) * ldb, wB + i * 8192);
  asm volatile("s_waitcnt vmcnt(0)" ::: "memory");
  __syncthreads();
  const int nk = K >> 6;
  for (int kt = 0; kt < nk; ++kt) {
    const int cur = kt & 1;
    if (kt + 1 < nk) {
#pragma unroll
      for (int i = 0; i < 4; ++i) glds16(ga + (size_t)(64 * i) * lda + (kt + 1) * 64, wA + (cur ^ 1) * 32768 + i * 8192);
#pragma unroll
      for (int i = 0; i < 2 * NBW; ++i) glds16(gb + (size_t)(64 * i) * ldb + (kt + 1) * 64, wB + (cur ^ 1) * BST + i * 8192);
    }
    const char* cA = sA + cur * 32768;
    const char* cB = sB + cur * BST;
    bf16x8 aa[2][4], bb[2][NBW];
    {
      const int co = (h ^ sx) << 4;
#pragma unroll
      for (int mb = 0; mb < 4; ++mb) aa[0][mb] = *(const bf16x8*)(cA + aoff + mb * 4096 + co);
#pragma unroll
      for (int nb = 0; nb < NBW; ++nb) bb[0][nb] = *(const bf16x8*)(cB + boff + nb * 4096 + co);
    }
#pragma unroll
    for (int ks = 0; ks < 4; ++ks) {
      if (ks < 3) {
        const int co = ((2 * (ks + 1) + h) ^ sx) << 4;
#pragma unroll
        for (int mb = 0; mb < 4; ++mb) aa[(ks + 1) & 1][mb] = *(const bf16x8*)(cA + aoff + mb * 4096 + co);
#pragma unroll
        for (int nb = 0; nb < NBW; ++nb) bb[(ks + 1) & 1][nb] = *(const bf16x8*)(cB + boff + nb * 4096 + co);
      }
#pragma unroll
      for (int mb = 0; mb < 4; ++mb)
#pragma unroll
        for (int nb = 0; nb < NBW; ++nb)
          acc[mb][nb] = TR ? mfma32(bb[ks & 1][nb], aa[ks & 1][mb], acc[mb][nb]) : mfma32(aa[ks & 1][mb], bb[ks & 1][nb], acc[mb][nb]);
      __builtin_amdgcn_sched_barrier(0);
    }
    asm volatile("s_waitcnt vmcnt(0) lgkmcnt(0)" ::: "memory");
    __builtin_amdgcn_s_barrier();
    asm volatile("" ::: "memory");
  }
}

DI void gemm_mainloop8(const u16* __restrict__ A, const u16* __restrict__ nA, int lda, const u16* __restrict__ BT, const u16* __restrict__ nBT, int ldb, int K,
                       f32x16 (&acc)[4][2], char* smem, const int tid_, const bool first, const bool last) {
  int tid = tid_;
  asm volatile("" : "+v"(tid));
  const int lane = tid & 63, w = tid >> 6;
  const int wr = w >> 2, wc = w & 3, h = lane >> 5, r31 = lane & 31;
  const int srow = tid >> 3;
  const int scol = ((tid & 7) ^ ((tid >> 4) & 7)) * 8;
  const unsigned oA = (unsigned)(srow * lda + scol) * 2u;
  const int rho = srow & 31;
  const int brow0 = (srow >> 5) * 64 + 16 * ((rho >> 2) & 1) + (rho & 3) + 4 * (rho >> 3);
  const unsigned oB = (unsigned)(brow0 * ldb + scol) * 2u;
  const unsigned ldaB = (unsigned)lda * 2u, ldbB = (unsigned)ldb * 2u;
  char* wdst = smem + __builtin_amdgcn_readfirstlane(w) * 1024;
  const int sx = (r31 >> 1) & 7;
  const int aoff = (wr * 64 + r31) * 128;
  const int boff = (wc * 32 + r31) * 128;
#define SA_(b, hf) (smem + ((b) * 2 + (hf)) * 16384)
#define SB_(b, hf) (smem + 65536 + ((b) * 2 + (hf)) * 16384)
#define STAGE_A(b, hf, kt) { const bool nx_ = (kt) >= nt; const u16* pa_ = nx_ ? nA : A; \
    const unsigned o_ = oA + (unsigned)((hf) * 128) * ldaB + (unsigned)(nx_ ? (kt) - nt : (kt)) * 128u; char* d_ = wdst + ((b) * 2 + (hf)) * 16384; \
    GLDS_SO(pa_, o_, d_); const unsigned o2_ = o_ + 64u * ldaB; GLDS_SO(pa_, o2_, d_ + 8192); }
#define STAGE_B(b, hf, kt) { const bool nx_ = (kt) >= nt; const u16* pb_ = nx_ ? nBT : BT; \
    const unsigned o_ = oB + (unsigned)((hf) * 32) * ldbB + (unsigned)(nx_ ? (kt) - nt : (kt)) * 128u; char* d_ = wdst + 65536 + ((b) * 2 + (hf)) * 16384; \
    GLDS_SO(pb_, o_, d_); const unsigned o2_ = o_ + 128u * ldbB; GLDS_SO(pb_, o2_, d_ + 8192); }
#define LDA_(dst, b, hf) _Pragma("unroll") for (int mb_ = 0; mb_ < 2; ++mb_) _Pragma("unroll") for (int ks_ = 0; ks_ < 4; ++ks_) \
    dst[mb_][ks_] = *(const bf16x8*)(SA_(b, hf) + aoff + mb_ * 4096 + (((2 * ks_ + h) ^ sx) << 4));
#define LDB_(dst, b, hf) _Pragma("unroll") for (int ks_ = 0; ks_ < 4; ++ks_) \
    dst[ks_] = *(const bf16x8*)(SB_(b, hf) + boff + (((2 * ks_ + h) ^ sx) << 4));
#define MMA_(ai, bj, At_, Bt_) { __builtin_amdgcn_s_setprio(1); \
    _Pragma("unroll") for (int mb_ = 0; mb_ < 2; ++mb_) _Pragma("unroll") for (int ks_ = 0; ks_ < 4; ++ks_) \
      acc[(ai) * 2 + mb_][bj] = mfma32(Bt_[ks_], At_[mb_][ks_], acc[(ai) * 2 + mb_][bj]); \
    __builtin_amdgcn_s_setprio(0); }
#define WAIT_V(n) asm volatile("s_waitcnt vmcnt(" #n ")" ::: "memory")
#define WAIT_L(n) asm volatile("s_waitcnt lgkmcnt(" #n ")" ::: "memory")
#define BAR __builtin_amdgcn_s_barrier()
#define SCHED __builtin_amdgcn_sched_barrier(0)
  bf16x8 At[2][4], B0[4], B1[4];
  const int nt = K >> 6;
  if (first) {
    STAGE_B(0, 0, 0); STAGE_A(0, 0, 0);
    STAGE_B(0, 1, 0); STAGE_A(0, 1, 0);
    if (wr == 1) BAR;
    WAIT_V(4); BAR;
    STAGE_B(1, 0, 1); STAGE_A(1, 0, 1); STAGE_B(1, 1, 1);
    WAIT_V(6); BAR;
  }
  for (int t = 0; t < nt; t += 2) {
    LDB_(B0, 0, 0); SCHED; LDA_(At, 0, 0); STAGE_A(1, 1, t + 1);
    WAIT_L(8); BAR; WAIT_L(0); MMA_(0, 0, At, B0); BAR; SCHED;
    LDB_(B1, 0, 1); STAGE_B(0, 0, t + 2);
    BAR; WAIT_L(0); MMA_(0, 1, At, B1); BAR;
    LDA_(At, 0, 1); STAGE_A(0, 0, t + 2);
    BAR; WAIT_L(0); MMA_(1, 0, At, B0); BAR; SCHED;
    STAGE_B(0, 1, t + 2);
    WAIT_V(6); BAR; MMA_(1, 1, At, B1); BAR;
    LDB_(B0, 1, 0); SCHED; LDA_(At, 1, 0); STAGE_A(0, 1, t + 2);
    WAIT_L(8); BAR; WAIT_L(0); MMA_(0, 0, At, B0); BAR; SCHED;
    LDB_(B1, 1, 1); STAGE_B(1, 0, t + 3);
    BAR; WAIT_L(0); MMA_(0, 1, At, B1); BAR;
    LDA_(At, 1, 1); STAGE_A(1, 0, t + 3);
    BAR; WAIT_L(0); MMA_(1, 0, At, B0); BAR; SCHED;
    STAGE_B(1, 1, t + 3);
    WAIT_V(6); BAR; MMA_(1, 1, At, B1); BAR;
  }
  if (last) {
    WAIT_V(0);
    if (wr == 0) BAR;
    __syncthreads();
  }
#undef SA_
#undef SB_
#undef STAGE_A
#undef STAGE_B
#undef LDA_
#undef LDB_
#undef MMA_
#undef WAIT_V
#undef WAIT_L
#undef BAR
#undef SCHED
}

DI bool tile_at(int it, int ntm, int ntn, int& tm, int& tn) {
  const int nloc = gridDim.x >> 3;
  const int L = (it * 8 + (blockIdx.x & 7)) * nloc + (blockIdx.x >> 3);
  if (L >= ntm * ntn) return false;
  const int full = ntn >> 2, pw = ntm * 4;
  int pnl, within, wd;
  if (L < full * pw) { pnl = L / pw; within = L - pnl * pw; wd = 4; }
  else { pnl = full; within = L - full * pw; wd = ntn - full * 4; }
  tm = within / wd;
  tn = pnl * 4 + within - tm * wd;
  return true;
}

template <int RB, int RS>
DI void flush_tile(const char* smem, char* gout, size_t ld_bytes, const int tid_) {
  constexpr int CPR = RB / 16;
  constexpr int PT = 256 * CPR / 512;
  int tid = tid_;
  asm volatile("" : "+v"(tid));
  __syncthreads();
#pragma unroll
  for (int i = 0; i < PT; ++i) {
    const int q = i * 512 + tid;
    const int row = q / CPR, c = q % CPR;
    const u32x4 v = *(const u32x4*)(smem + row * RS + c * 16);
    *(u32x4*)(gout + (size_t)row * ld_bytes + c * 16) = v;
  }
  __syncthreads();
}

#define ZERO_ACC(a, NBW_) _Pragma("unroll") for (int _m = 0; _m < 4; ++_m) _Pragma("unroll") for (int _n = 0; _n < NBW_; ++_n) _Pragma("unroll") for (int _i = 0; _i < 16; ++_i) a[_m][_n][_i] = 0.f;

template <int EPI, int KK>
DI void gemm_phase(const Params& p, int l, const u16* __restrict__ A, const u16* __restrict__ BT, int ntm, int ntn, char* smem) {
  constexpr int lda = KK, ldb = KK, K = KK;
  const int tid = opaque_tid(), lane = tid & 63, w = tid >> 6;
  const int wm = w >> 2, wn = w & 3, h = lane >> 5, r31 = lane & 31;
#define ROWOFF(mb_) ((((mb_) >> 1) * 128) + (((mb_) & 1) * 32))
  const bool split_ctx = (EPI == 0) && (ntm == MT / 256) && (gridDim.x >= 16);
  if (split_ctx) ntm = ML / 256;
  const int lrow0 = wm * 128 + 4 * h;
  bool first = true;
  for (int it = 0;; ++it) {
    int tm, tn;
    if (!tile_at(it, ntm, ntn, tm, tn)) break;
    const int m0 = tm * 256, n0 = tn * 256;
    const u16* cA = A + (size_t)m0 * lda;
    const u16* cB = BT + (size_t)n0 * ldb;
    const u16* nA = cA; const u16* nB = cB;
    bool last = true;
    {
      int tm2, tn2;
      if (tile_at(it + 1, ntm, ntn, tm2, tn2)) { nA = A + (size_t)tm2 * 256 * lda; nB = BT + (size_t)tn2 * 256 * ldb; last = false; }
    }
    f32x16 acc[4][2];
    ZERO_ACC(acc, 2);
    gemm_mainloop8(cA, nA, lda, cB, nB, ldb, K, acc, smem, tid, first, last);
    first = false;
    int te = tid;
    asm volatile("" : "+v"(te));
    const int lane = te & 63, w = te >> 6, wm = w >> 2, wn = w & 3, h = lane >> 5, r31 = lane & 31;
    const int lrow = wm * 64 + r31;
    const int c0 = n0 + wn * 64;
    if (EPI == 0) {
      char* gout = p.ws + OFF_T + ((size_t)(m0 + lrow) * 1024 + c0 + 16 * h) * 2;
#pragma unroll
      for (int mbx = 0; mbx < 4; ++mbx)
#pragma unroll
        for (int nb = 0; nb < 2; ++nb) {
          u32x4 lo, hi;
#pragma unroll
          for (int j = 0; j < 4; ++j) { lo[j] = pack2(acc[mbx][nb][2 * j], acc[mbx][nb][2 * j + 1]); hi[j] = pack2(acc[mbx][nb][8 + 2 * j], acc[mbx][nb][9 + 2 * j]); }
          char* g = gout + (size_t)ROWOFF(mbx) * 2048 + nb * 64;
          *(u32x4*)g = lo; *(u32x4*)(g + 16) = hi;
        }
    } else if (EPI == 1) {
      char* gout = p.ws + OFF_P + ((size_t)(m0 + lrow) * DFF + (n0 >> 1) + wn * 32 + 16 * h) * 2;
#pragma unroll
      for (int mbx = 0; mbx < 4; ++mbx) {
        f32x16 o;
#pragma unroll
        for (int i = 0; i < 16; ++i) {
          const float g = acc[mbx][0][i], u = acc[mbx][1][i];
          o[i] = g * __builtin_amdgcn_rcpf(1.f + __expf(-g)) * u;
        }
        u32x4 lo, hi;
#pragma unroll
        for (int j = 0; j < 4; ++j) { lo[j] = pack2(o[2 * j], o[2 * j + 1]); hi[j] = pack2(o[8 + 2 * j], o[9 + 2 * j]); }
        char* g = gout + (size_t)ROWOFF(mbx) * (DFF * 2);
        *(u32x4*)g = lo; *(u32x4*)(g + 16) = hi;
      }
    } else if (EPI == 2) {
      char* gout = p.ws + OFF_P + ((size_t)(m0 + lrow) * NGATE + c0 + 16 * h) * 2;
#pragma unroll
      for (int mbx = 0; mbx < 4; ++mbx)
#pragma unroll
        for (int nb = 0; nb < 2; ++nb) {
          f32x16 o;
#pragma unroll
          for (int i = 0; i < 16; ++i) o[i] = __builtin_amdgcn_rcpf(1.f + __expf(-acc[mbx][nb][i]));
          u32x4 lo, hi;
#pragma unroll
          for (int j = 0; j < 4; ++j) { lo[j] = pack2(o[2 * j], o[2 * j + 1]); hi[j] = pack2(o[8 + 2 * j], o[9 + 2 * j]); }
          char* g = gout + (size_t)ROWOFF(mbx) * (NGATE * 2) + nb * 64;
          *(u32x4*)g = lo; *(u32x4*)(g + 16) = hi;
        }
    } else {
      const int unit = c0 >> 6;
      bool rope = false, scale = false; int norm = -1;
      if (unit < 8) { rope = true; scale = true; }
      else if (unit < 16) { rope = true; }
      else if (unit < 24) { }
      else if (unit < 32) { scale = true; }
      else if (unit < 48) { }
      else if (unit < 56) { norm = 0; rope = true; scale = true; }
      else if (unit < 58) { norm = 1; rope = true; }
      else if (unit < 60) { }
      else if (unit < 68) { rope = true; scale = true; }
      else if (unit < 70) { rope = true; }
      const float qs = scale ? 0.125f * LOG2E : 1.f;
      char* gout = p.ws + OFF_P + ((size_t)(m0 + lrow) * NQKV + c0 + 16 * h) * 2;
#pragma unroll
      for (int mbx = 0; mbx < 4; ++mbx) {
        f32x16 x1 = acc[mbx][0], x2 = acc[mbx][1];
        if (norm >= 0) {
          const float* gain = p.qk_norm + (size_t)(l * 2 + norm) * 64 + h * 32;
          float ss = 0.f;
#pragma unroll
          for (int i = 0; i < 16; ++i) ss += x1[i] * x1[i] + x2[i] * x2[i];
          ss += __shfl_xor(ss, 32);
          const float rstd = rsqrtf(ss * (1.f / 64.f) + EPSN);
#pragma unroll
          for (int i = 0; i < 16; ++i) { x1[i] *= rstd * gain[i]; x2[i] *= rstd * gain[16 + i]; }
        }
        if (rope) {
          const int row = m0 + ROWOFF(mbx) + lrow;
          const bool lat = row < ML;
          const int t = row & 8191;
          const float pos = (float)(h ? (t & 63) : (t >> 6));
#pragma unroll
          for (int i = 0; i < 16; ++i) {
            const float ang = pos * exp2f(-(float)i * (13.287712379549449f / 16.f));
            const float cs = lat ? __cosf(ang) : 1.f, sn = lat ? __sinf(ang) : 0.f;
            const float a1 = x1[i], a2 = x2[i];
            x1[i] = a1 * cs - a2 * sn;
            x2[i] = a2 * cs + a1 * sn;
          }
        }
        u32x4 lo, hi;
        char* g = gout + (size_t)ROWOFF(mbx) * (NQKV * 2);
#pragma unroll
        for (int j = 0; j < 4; ++j) { lo[j] = pack2(x1[2 * j] * qs, x1[2 * j + 1] * qs); hi[j] = pack2(x1[8 + 2 * j] * qs, x1[9 + 2 * j] * qs); }
        *(u32x4*)g = lo; *(u32x4*)(g + 16) = hi;
#pragma unroll
        for (int j = 0; j < 4; ++j) { lo[j] = pack2(x2[2 * j] * qs, x2[2 * j + 1] * qs); hi[j] = pack2(x2[8 + 2 * j] * qs, x2[9 + 2 * j] * qs); }
        *(u32x4*)(g + 64) = lo; *(u32x4*)(g + 80) = hi;
      }
    }
  }
  if (EPI == 0) {
    if (split_ctx && blockIdx.x < 16) {
      const int m0 = ML + (blockIdx.x >> 3) * 256, n0 = (blockIdx.x & 7) * 128;
      f32x16 acc1[4][1];
      ZERO_ACC(acc1, 1);
      gemm_mainloop<1>(A + (size_t)m0 * lda, lda, BT + (size_t)n0 * ldb, ldb, K, acc1, smem, tid);
#pragma unroll
      for (int mb = 0; mb < 4; ++mb)
#pragma unroll
        for (int i = 0; i < 16; ++i) {
          const int lrow = lrow0 + mb * 32 + (i & 3) + 8 * (i >> 2);
          *(u16*)(smem + lrow * 272 + (wn * 32 + r31) * 2) = f2bf(acc1[mb][0][i]);
        }
      flush_tile<256, 272>(smem, p.ws + OFF_T + ((size_t)m0 * 1024 + n0) * 2, 1024 * 2, tid);
    }
  }
}

DI void branch_phase(const Params& p, int ntm, char* smem) {
  const int tid = opaque_tid();
  const u16* YS = (const u16*)(p.ws + OFF_T);
  const u16* WB = (const u16*)(p.ws + OFF_WB);
  const u16* G = (const u16*)(p.ws + OFF_P);
  u16* ACC = (u16*)(p.ws + OFF_U);
  for (int it = 0;; ++it) {
    int tm, tn;
    if (!tile_at(it, ntm, 8, tm, tn)) break;
    const int m0 = tm * 256, n0 = tn * 128;
    f32x16 tot[4];
#pragma unroll
    for (int mb = 0; mb < 4; ++mb)
#pragma unroll
      for (int i = 0; i < 16; ++i) tot[mb][i] = 0.f;
    for (int br = 0; br < 4; ++br) {
      int te = tid;
      asm volatile("" : "+v"(te));
      const int lane = te & 63, w = te >> 6, wm = w >> 2, wn = w & 3, h = lane >> 5, r31 = lane & 31;
      const u16* gp = G + (size_t)(m0 + wm * 128 + r31) * NGATE + br * 1024 + n0 + wn * 32 + 16 * h;
      u32x4 gq[4][2];
#pragma unroll
      for (int mb = 0; mb < 4; ++mb) {
        gq[mb][0] = *(const u32x4*)(gp + (size_t)(mb * 32) * NGATE);
        gq[mb][1] = *(const u32x4*)(gp + (size_t)(mb * 32) * NGATE + 8);
      }
      f32x16 acc[4][1];
      ZERO_ACC(acc, 1);
      gemm_mainloop<1, true>(YS + (size_t)m0 * 2048 + br * 512, 2048, WB + (size_t)br * 1024 * 512 + (size_t)n0 * 512, 512, 512, acc, smem, tid);
#pragma unroll
      for (int mb = 0; mb < 4; ++mb)
#pragma unroll
        for (int j = 0; j < 8; ++j) {
          const unsigned u = j < 4 ? gq[mb][0][j & 3] : gq[mb][1][j & 3];
          tot[mb][2 * j] += __uint_as_float(u << 16) * acc[mb][0][2 * j];
          tot[mb][2 * j + 1] += __uint_as_float(u & 0xffff0000u) * acc[mb][0][2 * j + 1];
        }
    }
    {
      int te = tid;
      asm volatile("" : "+v"(te));
      const int lane = te & 63, w = te >> 6, wm = w >> 2, wn = w & 3, h = lane >> 5, r31 = lane & 31;
      u16* op = ACC + (size_t)(m0 + wm * 128 + r31) * 1024 + n0 + wn * 32 + 16 * h;
#pragma unroll
      for (int mb = 0; mb < 4; ++mb) {
        u32x4 lo, hi;
#pragma unroll
        for (int j = 0; j < 4; ++j) { lo[j] = pack2(tot[mb][2 * j], tot[mb][2 * j + 1]); hi[j] = pack2(tot[mb][8 + 2 * j], tot[mb][9 + 2 * j]); }
        *(u32x4*)(op + (size_t)(mb * 32) * 1024) = lo;
        *(u32x4*)(op + (size_t)(mb * 32) * 1024 + 8) = hi;
      }
    }
  }
}

DI s16x4 tr_read(const char* a) {
  return __builtin_amdgcn_ds_read_tr16_b64_v4i16((s16x4 __attribute__((address_space(3)))*)(a));
}

template <int DV>
DI void attn_pass(const u16* __restrict__ P, int mode, int qrow0, int qcol, int kcol, int vcol,
                  int lat_row0, int nlat, int ctx_row0, int mq0, int mq1, int krlo,
                  const float* __restrict__ nab, float sink_l2, bool has_sink,
                  f32x16 (&O)[DV / 32], char* smem, const int tid) {
  constexpr int NDB = DV / 32;
  constexpr int VBUF = NDB * 4096;
  const int lane = tid & 63, w = tid >> 6, h = lane >> 5, r31 = lane & 31;
  char* sK = smem;
  char* sV = smem + 16384;
  float* sbias = (float*)(smem + 65536);

  bf16x8 qf[4];
  {
    const u16* qp = P + (size_t)(qrow0 + w * 32 + r31) * NQKV + qcol + 8 * h;
#pragma unroll
    for (int ks = 0; ks < 4; ++ks) qf[ks] = *(const bf16x8*)(qp + 16 * ks);
  }
  const u16* kbase = P + (size_t)(tid >> 3) * NQKV + kcol + ((tid & 7) ^ ((tid >> 4) & 7)) * 8;
  const u16* vbase = P + (size_t)((tid >> 2) & 63) * NQKV + vcol + ((tid >> 8) * 4 + (tid & 3)) * 8;
  char* wK = sK + tid * 16;
  char* wV = sV + tid * 16;
  const int nt = nlat + 4;

#define ATT_LOADK(t_, buf_)                                                                   \
  {                                                                                           \
    const int r0_ = (t_) < nlat ? lat_row0 + (t_) * 64 : ctx_row0 + ((t_) - nlat) * 64;       \
    const u16* kp_ = kbase + (size_t)r0_ * NQKV;                                              \
    glds16(kp_, wK + (buf_) * 8192);                                                          \
  }
#define ATT_LOADV(t_, buf_)                                                                   \
  {                                                                                           \
    const int r0_ = (t_) < nlat ? lat_row0 + (t_) * 64 : ctx_row0 + ((t_) - nlat) * 64;       \
    const u16* vp_ = vbase + (size_t)r0_ * NQKV;                                              \
    _Pragma("unroll") for (int i_ = 0; i_ < NDB / 2; ++i_) glds16(vp_ + i_ * 64, wV + (buf_) * VBUF + i_ * 8192); \
  }

  float m = -1e30f, lsum = 0.f;
#pragma unroll
  for (int db = 0; db < NDB; ++db)
#pragma unroll
    for (int i = 0; i < 16; ++i) O[db][i] = 0.f;

  const int sx = (r31 >> 1) & 7;
  const int i16 = lane & 15;
  const int troff = (4 * h + (i16 >> 2)) * 64 + 8 * (4 * ((lane >> 4) & 1) + (i16 & 3));
  const int na_rs = clampi(mq0 - 4, 0, 120);
  const int na_cs = clampi(mq1 - 8, 0, 48);
  const int koff = r31 * 128;

  auto qk = [&](f32x16 (&s)[2], const char* cK) __attribute__((always_inline)) {
    bf16x8 kf[2][4];
#pragma unroll
    for (int kb = 0; kb < 2; ++kb)
#pragma unroll
      for (int ks = 0; ks < 4; ++ks) kf[kb][ks] = *(const bf16x8*)(cK + kb * 4096 + koff + (((2 * ks + h) ^ sx) << 4));
#pragma unroll
    for (int kb = 0; kb < 2; ++kb) {
#pragma unroll
      for (int i = 0; i < 16; ++i) s[kb][i] = 0.f;
#pragma unroll
      for (int ks = 0; ks < 4; ++ks) s[kb] = mfma32(kf[kb][ks], qf[ks], s[kb]);
    }
  };
  auto process = [&](f32x16 (&s)[2], const char* cV, int t) __attribute__((always_inline)) {
    const bool masked = (mode != 0) && (t < nlat);
    if (masked) {
      if (mode == 1) {
        const int kp0 = mq1 + t * 64 + 4 * h - mq0;
#pragma unroll
        for (int kb = 0; kb < 2; ++kb)
#pragma unroll
          for (int i = 0; i < 16; ++i) {
            const int d = kp0 + kb * 32 + (i & 3) + 8 * (i >> 2);
            if (d > 128 || d < -128) s[kb][i] = -1e30f;
          }
      } else {
        const int krow = krlo + t;
        const float* nb = sbias + (krow - mq0 + 7) * 31 + 15 - mq1;
#pragma unroll
        for (int kb = 0; kb < 2; ++kb)
#pragma unroll
          for (int i = 0; i < 16; ++i) {
            const int kcx = kb * 32 + (i & 3) + 8 * (i >> 2) + 4 * h;
            const bool ok = (kcx >= na_cs) && (kcx < na_cs + 16);
            const float bias = nb[ok ? kcx : na_cs];
            s[kb][i] = ok ? s[kb][i] + bias : -1e30f;
          }
      }
    }
    float mx = s[0][0];
#pragma unroll
    for (int kb = 0; kb < 2; ++kb)
#pragma unroll
      for (int i = 0; i < 16; ++i) mx = fmaxf(mx, s[kb][i]);
    mx = fmaxf(mx, __shfl_xor(mx, 32));
    if (__any(mx > m + 8.f)) {
      const float mn = fmaxf(m, mx);
      const float alpha = fexp2(m - mn);
      m = mn;
      lsum *= alpha;
#pragma unroll
      for (int db = 0; db < NDB; ++db)
#pragma unroll
        for (int i = 0; i < 16; ++i) O[db][i] *= alpha;
    }
    float ps = 0.f;
#pragma unroll
    for (int kb = 0; kb < 2; ++kb)
#pragma unroll
      for (int i = 0; i < 16; ++i) { const float pv = fexp2(s[kb][i] - m); s[kb][i] = pv; ps += pv; }
    lsum += ps;
    bf16x8 pf[2][2];
#pragma unroll
    for (int kb = 0; kb < 2; ++kb)
#pragma unroll
      for (int s2 = 0; s2 < 2; ++s2) {
        u32x4 u;
#pragma unroll
        for (int jj = 0; jj < 4; ++jj) u[jj] = pack2(s[kb][8 * s2 + 2 * jj], s[kb][8 * s2 + 2 * jj + 1]);
        pf[kb][s2] = __builtin_bit_cast(bf16x8, u);
      }
    constexpr int NF = NDB * 4;
    s16x4 vlo[4], vhi[4];
#pragma unroll
    for (int f = 0; f < 4; ++f) {
      const char* a = cV + (f >> 2) * 4096 + (((f >> 1) & 1) * 32 + 16 * (f & 1)) * 64 + troff;
      vlo[f] = tr_read(a);
      vhi[f] = tr_read(a + 8 * 64);
    }
#pragma unroll
    for (int f = 0; f < NF; ++f) {
      const bf16x8 vf = __builtin_shufflevector(vlo[f & 3], vhi[f & 3], 0, 1, 2, 3, 4, 5, 6, 7);
      if (f + 4 < NF) {
        const int g = f + 4;
        const char* a = cV + (g >> 2) * 4096 + (((g >> 1) & 1) * 32 + 16 * (g & 1)) * 64 + troff;
        vlo[f & 3] = tr_read(a);
        vhi[f & 3] = tr_read(a + 8 * 64);
      }
      O[f >> 2] = mfma32(vf, pf[(f >> 1) & 1][f & 1], O[f >> 2]);
    }
  };
  auto step = [&](f32x16 (&sc)[2], f32x16 (&sn)[2], int t) __attribute__((always_inline)) {
    const int cur = t & 1;
    if (t + 2 < nt) ATT_LOADK(t + 2, cur);
    if (t + 1 < nt) {
      ATT_LOADV(t + 1, cur ^ 1);
      qk(sn, sK + (cur ^ 1) * 8192);
    }
    bool active = true;
    if (mode == 2 && t < nlat) { const int krow = krlo + t; active = (krow >= na_rs) && (krow < na_rs + 8); }
    if (active) process(sc, sV + cur * VBUF, t);
    asm volatile("s_waitcnt vmcnt(0) lgkmcnt(0)" ::: "memory");
    __builtin_amdgcn_s_barrier();
    asm volatile("" ::: "memory");
  };

  ATT_LOADK(0, 0);
  ATT_LOADV(0, 0);
  ATT_LOADK(1, 1);
  if (mode == 2) {
    for (int i = tid; i < 15 * 31; i += 512) sbias[i] = nab[i] * LOG2E;
  }
  asm volatile("s_waitcnt vmcnt(0)" ::: "memory");
  __syncthreads();
  f32x16 sa[2], sb[2];
  qk(sa, sK);
  __syncthreads();
  for (int t = 0; t < nt; t += 2) {
    step(sa, sb, t);
    if (t + 1 < nt) step(sb, sa, t + 1);
  }
  float lt = lsum + __shfl_xor(lsum, 32);
  if (has_sink) lt += fexp2(sink_l2 - m);
  const float inv = 1.f / lt;
#pragma unroll
  for (int db = 0; db < NDB; ++db)
#pragma unroll
    for (int i = 0; i < 16; ++i) O[db][i] *= inv;
#undef ATT_LOADK
#undef ATT_LOADV
}

template <int NDB>
DI void store_ys(u16* __restrict__ YS, int row, int col, const f32x16 (&O)[NDB], int h) {
#pragma unroll
  for (int db = 0; db < NDB; ++db)
#pragma unroll
    for (int g = 0; g < 4; ++g) {
      u32x2 o = {pack2(O[db][4 * g], O[db][4 * g + 1]), pack2(O[db][4 * g + 2], O[db][4 * g + 3])};
      *(u32x2*)(YS + (size_t)row * 2048 + col + db * 32 + 8 * g + 4 * h) = o;
    }
}

DI void attn_phase(const Params& p, int l, int rep, char* smem) {
  __shared__ int s_item;
  const int tid = opaque_tid(), lane = tid & 63, w = tid >> 6, h = lane >> 5, r31 = lane & 31;
  const int nitems = (l == 0) ? 1848 : 1792;
  int* counter = (int*)(p.ws + OFF_BAR) + l + 2 * rep;
  const u16* P = (const u16*)(p.ws + OFF_P);
  u16* YS = (u16*)(p.ws + OFF_T);
  const float lam = ((const float*)(p.ws + OFF_MISC + 64))[l];
  const float lam_init = 0.8f - 0.6f * expf(-0.3f * (float)l);
  float* stash = (float*)(p.ws + OFF_STASH + (size_t)blockIdx.x * 131072);
  for (;;) {
    if (tid == 0) s_item = atomicAdd(counter, 1);
    __syncthreads();
    const int item = s_item;
    __syncthreads();
    if (item >= nitems) break;
    int type, b, hd, qb; bool isctx = false;
    if (item < 256) { type = 0; b = item >> 7; hd = (item >> 5) & 3; qb = item & 31; }
    else if (item < 1792) {
      const int j = (item - 256) & 511;
      const int seg = (item - 256) >> 9;
      type = seg == 0 ? 2 : (seg == 1 ? 3 : 1);
      b = j >> 8; hd = (j >> 5) & 7; qb = j & 31;
    } else {
      isctx = true; qb = 0;
      int j = item - 1792;
      if (j < 8) { type = 0; b = j >> 2; hd = j & 3; }
      else { j -= 8; const int seg = j >> 4; j &= 15; type = seg + 1; b = j >> 3; hd = j & 7; }
    }
    const int ctx_row0 = ML + b * 256;
    const int qrow0 = isctx ? ctx_row0 : b * 8192 + qb * 256;
    const int row = qrow0 + w * 32 + r31;
    if (type == 0) {
      f32x16 O[4];
      for (int pass = 0; pass < 2; ++pass) {
        attn_pass<128>(P, 0, qrow0, hd * 128 + pass * 64, 512 + hd * 128 + pass * 64, 1024 + hd * 128,
                       b * 8192, isctx ? 0 : 128, ctx_row0, 0, 0, 0, nullptr, 0.f, false, O, smem, tid);
        if (pass == 0) {
          float4* st = (float4*)(stash + tid * 64);
#pragma unroll
          for (int db = 0; db < 4; ++db)
#pragma unroll
            for (int g = 0; g < 4; ++g) st[db * 4 + g] = make_float4(O[db][4 * g], O[db][4 * g + 1], O[db][4 * g + 2], O[db][4 * g + 3]);
        }
      }
      float ss = 0.f;
      const float4* st = (const float4*)(stash + tid * 64);
#pragma unroll
      for (int db = 0; db < 4; ++db)
#pragma unroll
        for (int g = 0; g < 4; ++g) {
          const float4 sv = st[db * 4 + g];
          const float d0 = sv.x - lam * O[db][4 * g], d1 = sv.y - lam * O[db][4 * g + 1];
          const float d2 = sv.z - lam * O[db][4 * g + 2], d3 = sv.w - lam * O[db][4 * g + 3];
          O[db][4 * g] = d0; O[db][4 * g + 1] = d1; O[db][4 * g + 2] = d2; O[db][4 * g + 3] = d3;
          ss += d0 * d0 + d1 * d1 + d2 * d2 + d3 * d3;
        }
      ss += __shfl_xor(ss, 32);
      const float rstd = rsqrtf(ss * (1.f / 128.f) + EPSN) * (1.f - lam_init);
      const float* sub = p.diff_subln + l * 128;
#pragma unroll
      for (int db = 0; db < 4; ++db)
#pragma unroll
        for (int i = 0; i < 16; ++i) O[db][i] *= rstd * sub[db * 32 + (i & 3) + 8 * (i >> 2) + 4 * h];
      store_ys<4>(YS, row, hd * 128, O, h);
    } else {
      f32x16 O[2];
      int mode = 0, qcol, kcol, vcol, lat_row0 = b * 8192, nlat = isctx ? 0 : 128, mq0 = 0, mq1 = 0, krlo = 0, outcol;
      float sink_l2 = 0.f; bool has_sink = false;
      if (type == 1) {
        const int r0 = 4 * qb;
        krlo = clampi(r0 - 4, 0, 120);
        const int krhi = clampi(r0 - 1, 0, 120) + 7;
        if (!isctx) { mode = 2; nlat = krhi - krlo + 1; lat_row0 = b * 8192 + krlo * 64; }
        mq0 = r0 + (w >> 1); mq1 = (w & 1) * 32 + r31;
        qcol = 1536 + hd * 64; kcol = 2048 + hd * 64; vcol = 2560 + hd * 64; outcol = 512 + hd * 64;
      } else if (type == 2) {
        qcol = 3072 + hd * 64; kcol = 3584 + (hd >> 2) * 64; vcol = 3712 + (hd >> 2) * 64; outcol = 1024 + hd * 64;
      } else {
        const int start = qb > 0 ? qb * 256 - 128 : 0;
        const int end = qb < 31 ? qb * 256 + 384 : 8192;
        if (!isctx) { mode = 1; nlat = (end - start) >> 6; lat_row0 = b * 8192 + start; }
        mq0 = qb * 256 + w * 32 + r31; mq1 = start;
        sink_l2 = p.sink[l * 8 + hd] * LOG2E; has_sink = true;
        qcol = 3840 + hd * 64; kcol = 4352 + (hd >> 2) * 64; vcol = 4480 + (hd >> 2) * 64; outcol = 1536 + hd * 64;
      }
      attn_pass<64>(P, mode, qrow0, qcol, kcol, vcol, lat_row0, nlat, ctx_row0, mq0, mq1, krlo,
                    p.na_bias + (size_t)(l * 8 + hd) * 15 * 31, sink_l2, has_sink, O, smem, tid);
      store_ys<2>(YS, row, outcol, O, h);
    }
  }
}


#define XB_TMO      128
#define XB_XCNT(j)  (256  + 64 * (j))
#define XB_XSUB(j)  (1280 + 64 * (j))
#define XB_XGEN(j)  (2304 + 64 * (j))
#define XB_TOP      3328
#define XB_TOPGEN   3392
#define XCD_BAR_WORDS 3456
#define XB_SPIN_CAP (1u << 22)
DI unsigned xb_ld(unsigned* q) { return __hip_atomic_load(q, __ATOMIC_RELAXED, __HIP_MEMORY_SCOPE_AGENT); }
DI unsigned xb_add(unsigned* q, unsigned v) { return __hip_atomic_fetch_add(q, v, __ATOMIC_RELAXED, __HIP_MEMORY_SCOPE_AGENT); }
DI unsigned xb_xcc_id() { return (unsigned)__builtin_amdgcn_s_getreg((3 << 11) | 20) & 0xFu; }
#define XB_SPIN(cond, bar) do { unsigned _sp = 0; while (cond) { __builtin_amdgcn_s_sleep(1); \
    if ((++_sp & 255u) == 0u) { if (xb_ld(&(bar)[XB_TMO])) break; if (_sp > XB_SPIN_CAP) { atomicAdd(&(bar)[XB_TMO], 1u); break; } } } } while (0)
struct XcdBarrier { unsigned* bar; unsigned x; volatile LAS unsigned* st; };
DI XcdBarrier xcd_barrier_post(unsigned* bar, volatile LAS unsigned* st) {
  XcdBarrier b; b.bar = bar; b.x = xb_xcc_id(); b.st = st;
  if (threadIdx.x == 0) (void)xb_add(&bar[XB_XCNT(b.x)], 1u);
  return b;
}
DI void xcd_barrier_complete(unsigned* bar, unsigned x, unsigned& nloc, unsigned& nx) {
  const unsigned G = gridDim.x * gridDim.y * gridDim.z;
  unsigned sum, cnt, mine, sp = 0u;
  for (;;) {
    sum = 0u; cnt = 0u; mine = 0u;
#pragma unroll
    for (unsigned j = 0; j < 16; ++j) { const unsigned c = xb_ld(&bar[XB_XCNT(j)]); sum += c; cnt += (c > 0u) ? 1u : 0u; mine = (j == x) ? c : mine; }
    if (sum == G) break;
    __builtin_amdgcn_s_sleep(1);
    if ((++sp & 255u) == 0u) { if (xb_ld(&bar[XB_TMO])) break; if (sp > XB_SPIN_CAP) { atomicAdd(&bar[XB_TMO], 1u); break; } }
  }
  nloc = mine > 0u ? mine : 1u; nx = cnt > 0u ? cnt : 1u;
}
DI void xcd_barrier(const XcdBarrier& b) {
  asm volatile("s_waitcnt vmcnt(0)" ::: "memory");
  __syncthreads();
  if (threadIdx.x == 0) {
    unsigned* bar = b.bar;
    __builtin_amdgcn_s_waitcnt(0);
    unsigned nloc = b.st[0], nx = b.st[1];
    if (nloc == 0u) { xcd_barrier_complete(bar, b.x, nloc, nx); b.st[0] = nloc; b.st[1] = nx; }
    const unsigned old = xb_add(&bar[XB_XSUB(b.x)], 1u);
    const unsigned gen = old / nloc;
    if (old + 1u == (gen + 1u) * nloc) {
      __builtin_amdgcn_fence(__ATOMIC_RELEASE, "agent");
      asm volatile("s_waitcnt vmcnt(0)" ::: "memory");
      const unsigned og = xb_add(&bar[XB_TOP], 1u);
      const unsigned tg = og / nx;
      if (og + 1u == (tg + 1u) * nx) xb_add(&bar[XB_TOPGEN], 1u);
      else XB_SPIN(xb_ld(&bar[XB_TOPGEN]) == tg, bar);
      __builtin_amdgcn_fence(__ATOMIC_ACQUIRE, "agent");
      xb_add(&bar[XB_XGEN(b.x)], 1u);
      asm volatile("s_waitcnt vmcnt(0)" ::: "memory");
    } else {
      XB_SPIN(xb_ld(&bar[XB_XGEN(b.x)]) == gen, bar);
      __builtin_amdgcn_fence(__ATOMIC_ACQUIRE, "agent");
      asm volatile("s_waitcnt vmcnt(0)" ::: "memory");
    }
  }
  __syncthreads();
}

__global__ void __launch_bounds__(512, 2) mk_forward(Params p) {
  __shared__ __attribute__((aligned(16))) char smem[135168];
  __shared__ uint4 xb_words;
  cg::grid_group grid = cg::this_grid();
  if (threadIdx.x == 0) xb_words = make_uint4(0u, 0u, 0u, 0u);
  __syncthreads();
  XcdBarrier xb = xcd_barrier_post((unsigned*)(p.ws + OFF_BAR), (volatile LAS unsigned*)&xb_words);
#if MK_MULTI
  const int ph_lo = p.phase_lo, ph_hi = p.phase_hi; const bool coop = false;
#else
  constexpr int ph_lo = 0, ph_hi = NPHASE; constexpr bool coop = true;
#endif
  for (int ph = ph_lo; ph < ph_hi; ++ph) {
    char* ws = opaque_ws(p.ws);
    const u16* U = (const u16*)(ws + OFF_U);
    const u16* PB = (const u16*)(ws + OFF_P);
    if (ph == 0) { for (int rep = 0; rep < REP_INIT; ++rep) phase_init(p, smem); }
    else {
      const int l = ph == 1 ? 0 : (ph - 2) / 12, s = ph == 1 ? 12 : (ph - 2) % 12;
      int epi = -1, lda = 1024, ldb = 1024, K = 1024, ntn = 4;
      const u16* A = U; const u16* BT = nullptr;
      switch (s) {
        case 0: epi = 1; BT = (const u16*)(ws + OFF_WGU1); ntn = 22; break;
        case 1: epi = 0; A = PB; lda = DFF; BT = (const u16*)(ws + OFF_WD1); ldb = DFF; K = DFF; break;
        case 3: epi = 3; BT = (const u16*)(ws + OFF_WIN); ntn = 18; break;
        case 5: epi = 2; BT = (const u16*)(ws + OFF_WIN) + (size_t)NQKV * 1024; ntn = 16; break;
        case 7: epi = 0; BT = (const u16*)(ws + OFF_WOUT); break;
        case 9: epi = 1; BT = (const u16*)(ws + OFF_WGU2); ntn = 22; break;
        case 10: epi = 0; A = PB; lda = DFF; BT = (const u16*)(ws + OFF_WD2); ldb = DFF; K = DFF; break;
        default: break;
      }
      if (epi >= 0 || s == 6) {
        for (int rep = 0; rep < REP_GEMM; ++rep) {
          const int ntm = (l == 1 && s >= 5) ? ML / 256 : MT / 256;
          if (epi == 0) { if (K == DFF) gemm_phase<0, DFF>(p, l, A, BT, ntm, ntn, smem); else gemm_phase<0, 1024>(p, l, A, BT, ntm, ntn, smem); }
          else if (epi == 1) gemm_phase<1, 1024>(p, l, A, BT, ntm, ntn, smem);
          else if (epi == 2) gemm_phase<2, 1024>(p, l, A, BT, ntm, ntn, smem);
          else if (epi == 3) gemm_phase<3, 1024>(p, l, A, BT, ntm, ntn, smem);
          else branch_phase(p, ntm, smem);
        }
      } else if (s == 4) {
        for (int rep = 0; rep < REP_ATT; ++rep) attn_phase(p, l, rep, smem);
      }
      else {
        const int rmode = s == 12 ? 0 : (s == 2 ? 1 : (s == 8 ? 2 : 3));
        rowpass(p, l, rmode);
        if (rmode == 0) { for (int rep = 1; rep < REP_ROW0; ++rep) rowpass(p, l, rmode); }
        if (rmode == 3 && l + 1 < 2) {
          for (int it = blockIdx.x; it < 1792; it += gridDim.x) convert_pair(p, l + 1, 4 * it, (float*)smem);
        }
      }
    }
    if (coop && ph + 1 < ph_hi) {
      if (ph == ph_lo) grid.sync();
      else { for (int rs = 0; rs < REP_SYNC; ++rs) xcd_barrier(xb); }
    }
  }
}

extern "C" void kernel_launch(void* const* d_in, const int* in_sizes, int n_in, void* d_out, int out_size, void* d_ws, size_t ws_size,
                              hipStream_t stream) {
  static int grid_blocks = 0;
  if (!grid_blocks) {
    int dev = 0, cus = 0, per_cu = 0;
    hipGetDevice(&dev);
    hipDeviceGetAttribute(&cus, hipDeviceAttributeMultiprocessorCount, dev);
    hipOccupancyMaxActiveBlocksPerMultiprocessor(&per_cu, mk_forward, 512, 0);
    if (per_cu > 1) per_cu = 1;
    if (per_cu < 1) per_cu = 1;
    grid_blocks = cus * per_cu;
    const size_t need = OFF_STASH + (size_t)grid_blocks * 131072;
    if (need > ws_size) fprintf(stderr, "workspace too small: need %zu have %zu\n", need, ws_size);
  }
  Params p{};
  p.x = (const float*)d_in[0]; p.c = (const float*)d_in[1]; p.ctx = (const float*)d_in[2]; p.c_ctx = (const float*)d_in[3];
  p.w_mod = (const float*)d_in[4]; p.b_mod = (const float*)d_in[5]; p.norm_gain = (const float*)d_in[6];
  p.wg = (const float*)d_in[7]; p.wu = (const float*)d_in[8]; p.wd = (const float*)d_in[9];
  p.w_in = (const float*)d_in[10]; p.w_branch = (const float*)d_in[11]; p.w_out = (const float*)d_in[12];
  p.diff_lambda = (const float*)d_in[13]; p.diff_subln = (const float*)d_in[14]; p.na_bias = (const float*)d_in[15];
  p.qk_norm = (const float*)d_in[16]; p.sink = (const float*)d_in[17];
  p.out = (float*)d_out; p.ws = (char*)d_ws;
  p.pad = 0;
  hipMemsetAsync((char*)d_ws + OFF_BAR, 0, 16384, stream);
#if MK_MULTI
  for (int ph = 0; ph < NPHASE; ++ph) {
    p.phase_lo = ph; p.phase_hi = ph + 1; p.coop = 0;
    hipLaunchKernelGGL(mk_forward, dim3(grid_blocks), dim3(512), 0, stream, p);
  }
#else
  p.phase_lo = 0; p.phase_hi = NPHASE; p.coop = 1;
  void* args[] = {&p};
  hipError_t e = hipLaunchCooperativeKernel((void*)mk_forward, dim3(grid_blocks), dim3(512), args, 0, stream);
  if (e != hipSuccess) fprintf(stderr, "cooperative launch failed: %s (grid %d)\n", hipGetErrorString(e), grid_blocks);
#endif
}
```

```cpp
#include <hip/hip_runtime.h>
#include <hip/hip_cooperative_groups.h>
#include <cstdio>
namespace cg = cooperative_groups;

typedef unsigned short u16;
typedef short bf16x8 __attribute__((ext_vector_type(8)));
typedef short s16x4 __attribute__((ext_vector_type(4)));
typedef float f32x16 __attribute__((ext_vector_type(16)));
typedef float f32x2 __attribute__((ext_vector_type(2)));
typedef __bf16 bf16x2v __attribute__((ext_vector_type(2)));
typedef unsigned u32x4 __attribute__((ext_vector_type(4)));
typedef unsigned u32x2 __attribute__((ext_vector_type(2)));

#define DI __device__ __forceinline__

#ifndef MK_MULTI
#define MK_MULTI 0
#endif
#define REP_GEMM 1
#define REP_ATT 1
#define REP_SYNC 1
#define REP_INIT 1
#define REP_ROW0 1

constexpr int ML = 16384;
constexpr int MT = 16896;
constexpr int DFF = 2816;
constexpr int NQKV = 4608;
constexpr int NGATE = 4096;
constexpr float LOG2E = 1.4426950408889634f;
constexpr float EPSN = 1e-6f;
constexpr int NPHASE = 26;

constexpr size_t SZ_WGU = (size_t)5632 * 1024 * 2;
constexpr size_t SZ_WD = (size_t)1024 * 2816 * 2;
constexpr size_t OFF_WGU1 = 0;
constexpr size_t OFF_WD1 = OFF_WGU1 + SZ_WGU;
constexpr size_t OFF_WGU2 = OFF_WD1 + SZ_WD;
constexpr size_t OFF_WD2 = OFF_WGU2 + SZ_WGU;
constexpr size_t OFF_WIN = OFF_WD2 + SZ_WD;
constexpr size_t OFF_WB = OFF_WIN + (size_t)8704 * 1024 * 2;
constexpr size_t OFF_WOUT = OFF_WB + (size_t)4 * 1024 * 512 * 2;
constexpr size_t OFF_U = OFF_WOUT + (size_t)1024 * 1024 * 2;
constexpr size_t OFF_T = OFF_U + (size_t)MT * 1024 * 2;
constexpr size_t OFF_P = OFF_T + (size_t)MT * 1024 * 4;
constexpr size_t OFF_HC = OFF_P + (size_t)MT * NQKV * 2;
constexpr size_t OFF_MOD = OFF_HC + (size_t)512 * 1024 * 4;
constexpr size_t OFF_MISC = OFF_MOD + (size_t)2 * 3 * 9216 * 4;
constexpr size_t OFF_BAR = OFF_MISC + 4096;
constexpr size_t OFF_STASH = OFF_BAR + 16384;

struct Params {
  const float *x, *c, *ctx, *c_ctx, *w_mod, *b_mod, *norm_gain, *wg, *wu, *wd, *w_in, *w_branch, *w_out;
  const float *diff_lambda, *diff_subln, *na_bias, *qk_norm, *sink;
  float* out;
  char* ws;
  int phase_lo, phase_hi, coop, pad;
};

DI unsigned pack2(float a, float b) {
  f32x2 v = {a, b};
  return __builtin_bit_cast(unsigned, __builtin_convertvector(v, bf16x2v));
}
DI u16 f2bf(float a) { return (u16)(pack2(a, 0.f) & 0xffffu); }
DI float bf2f(u16 v) { return __uint_as_float(((unsigned)v) << 16); }
DI f32x16 mfma32(bf16x8 a, bf16x8 b, f32x16 c) { return __builtin_amdgcn_mfma_f32_32x32x16_bf16(a, b, c, 0, 0, 0); }
DI float fexp2(float x) { return __builtin_amdgcn_exp2f(x); }
DI float wave_sum(float v) {
#pragma unroll
  for (int o = 32; o > 0; o >>= 1) v += __shfl_xor(v, o);
  return v;
}
DI int opaque_tid() { int t = threadIdx.x; asm volatile("" : "+v"(t)); return t; }
DI char* opaque_ws(char* q) { size_t z = 0; asm volatile("" : "+s"(z)); return q + z; }
DI int clampi(int v, int lo, int hi) { return v < lo ? lo : (v > hi ? hi : v); }
DI int crow(int i, int h) { return (i & 3) + 8 * (i >> 2) + 4 * h; }

DI void modgemv_item(const Params& p, int it, float* sm) {
  const int l = it / 144, n0 = (it % 144) * 64;
  float* s_in = sm;
  float* red = sm + 3072;
  const int tid = opaque_tid();
  for (int i = tid; i < 3072; i += 512) {
    const int v = i >> 10, k = i & 1023;
    const float xv = v < 2 ? p.c[v * 1024 + k] : p.c_ctx[k];
    s_in[i] = xv / (1.f + __expf(-xv));
  }
  __syncthreads();
  const int kg = tid >> 4, c4 = tid & 15;
  const float* w = p.w_mod + (size_t)l * 1024 * 9216 + n0 + c4 * 4;
  float a0x = 0, a0y = 0, a0z = 0, a0w = 0, a1x = 0, a1y = 0, a1z = 0, a1w = 0, a2x = 0, a2y = 0, a2z = 0, a2w = 0;
#pragma unroll 8
  for (int kk = 0; kk < 32; ++kk) {
    const int k = kg * 32 + kk;
    const float4 wv = *(const float4*)(w + (size_t)k * 9216);
    const float s0 = s_in[k], s1 = s_in[1024 + k], s2 = s_in[2048 + k];
    a0x += s0 * wv.x; a0y += s0 * wv.y; a0z += s0 * wv.z; a0w += s0 * wv.w;
    a1x += s1 * wv.x; a1y += s1 * wv.y; a1z += s1 * wv.z; a1w += s1 * wv.w;
    a2x += s2 * wv.x; a2y += s2 * wv.y; a2z += s2 * wv.z; a2w += s2 * wv.w;
  }
  float* r0 = red + (kg * 3 + 0) * 64 + c4 * 4;
  r0[0] = a0x; r0[1] = a0y; r0[2] = a0z; r0[3] = a0w;
  float* r1 = red + (kg * 3 + 1) * 64 + c4 * 4;
  r1[0] = a1x; r1[1] = a1y; r1[2] = a1z; r1[3] = a1w;
  float* r2 = red + (kg * 3 + 2) * 64 + c4 * 4;
  r2[0] = a2x; r2[1] = a2y; r2[2] = a2z; r2[3] = a2w;
  __syncthreads();
  if (tid < 192) {
    const int v = tid >> 6, cc = tid & 63;
    float s = 0.f;
#pragma unroll
    for (int g = 0; g < 32; ++g) s += red[(g * 3 + v) * 64 + cc];
    s += p.b_mod[l * 9216 + n0 + cc];
    float* mod = (float*)(p.ws + OFF_MOD);
    mod[(l * 3 + v) * 9216 + n0 + cc] = s;
  }
  __syncthreads();
}

DI int qk_perm(int d) { return ((d >> 4) & 1) * 32 + (d >> 5) * 16 + (d & 15); }
DI int mapcol(int mode, int n) {
  if (mode == 0) return n;
  if (mode == 1) return (n >> 5) * 64 + (n & 31);
  if (mode == 2) return (n >> 5) * 64 + 32 + (n & 31);
  const int unit = n >> 6;
  const bool qk = (unit < 16) || (unit >= 24 && unit < 40) || (unit >= 48 && unit < 58) || (unit >= 60 && unit < 70);
  return qk ? ((n & ~63) + qk_perm(n & 63)) : n;
}

struct ConvJob { const float* src; u16* dst; int N, ldd, mode, k0, n0; };
DI ConvJob convert_job(const Params& p, int l, int j) {
  ConvJob c; int K;
  if (j < 4224) {
    const int sub = j / 2112; int jj = j - sub * 2112;
    const int which = jj / 704; jj -= which * 704;
    const size_t lw = (size_t)(l * 2 + sub) * 1024 * 2816;
    if (which == 0) { c.src = p.wg + lw; K = 1024; c.N = 2816; c.mode = 1; c.dst = (u16*)(p.ws + (sub ? OFF_WGU2 : OFF_WGU1)); }
    else if (which == 1) { c.src = p.wu + lw; K = 1024; c.N = 2816; c.mode = 2; c.dst = (u16*)(p.ws + (sub ? OFF_WGU2 : OFF_WGU1)); }
    else { c.src = p.wd + lw; K = 2816; c.N = 1024; c.mode = 0; c.dst = (u16*)(p.ws + (sub ? OFF_WD2 : OFF_WD1)); }
    j = jj;
  } else if (j < 6400) {
    j -= 4224; c.src = p.w_in + (size_t)l * 1024 * 8704; K = 1024; c.N = 8704; c.mode = 3; c.dst = (u16*)(p.ws + OFF_WIN);
  } else if (j < 6912) {
    j -= 6400; const int i = j >> 7; j &= 127;
    c.src = p.w_branch + (size_t)(l * 4 + i) * 512 * 1024; K = 512; c.N = 1024; c.mode = 0; c.dst = (u16*)(p.ws + OFF_WB) + (size_t)i * 1024 * 512;
  } else {
    j -= 6912; c.src = p.w_out + (size_t)l * 1024 * 1024; K = 1024; c.N = 1024; c.mode = 0; c.dst = (u16*)(p.ws + OFF_WOUT);
  }
  const int nk = K >> 6;
  c.k0 = (j % nk) * 64; c.n0 = (j / nk) * 64; c.ldd = K;
  return c;
}

DI void convert_pair(const Params& p, int l, int jbase, float* sm0) {
  const int tid512 = opaque_tid();
  const int half = tid512 >> 8, tid = tid512 & 255;
  float* sm = sm0 + half * 8320;
  const int j0 = jbase + 2 * half, j1 = jbase + 2 * half + 1;
  const int r = tid >> 4, c4 = tid & 15;
  const bool two = j1 >= 0;
  const ConvJob a = convert_job(p, l, j0);
  const ConvJob b = convert_job(p, l, two ? j1 : j0);
  float4 va[4], vb[4];
#pragma unroll
  for (int i = 0; i < 4; ++i) va[i] = *(const float4*)(a.src + (size_t)(a.k0 + r + 16 * i) * a.N + a.n0 + c4 * 4);
  if (two) {
#pragma unroll
    for (int i = 0; i < 4; ++i) vb[i] = *(const float4*)(b.src + (size_t)(b.k0 + r + 16 * i) * b.N + b.n0 + c4 * 4);
  }
#pragma unroll
  for (int i = 0; i < 4; ++i) {
    float* d = sm + (r + 16 * i) * 65 + c4 * 4;
    d[0] = va[i].x; d[1] = va[i].y; d[2] = va[i].z; d[3] = va[i].w;
  }
  if (two) {
#pragma unroll
    for (int i = 0; i < 4; ++i) {
      float* d = sm + 4160 + (r + 16 * i) * 65 + c4 * 4;
      d[0] = vb[i].x; d[1] = vb[i].y; d[2] = vb[i].z; d[3] = vb[i].w;
    }
  }
  __syncthreads();
#pragma unroll
  for (int t = 0; t < 2; ++t) {
    if (t == 1 && !two) break;
    const ConvJob& c = t ? b : a;
    const float* st = sm + t * 4160;
#pragma unroll
    for (int i = 0; i < 2; ++i) {
      const int n = (tid >> 3) + 32 * i, k8 = tid & 7;
      u32x4 o;
#pragma unroll
      for (int j = 0; j < 4; ++j) o[j] = pack2(st[(k8 * 8 + 2 * j) * 65 + n], st[(k8 * 8 + 2 * j + 1) * 65 + n]);
      const int nn = mapcol(c.mode, c.n0 + n);
      *(u32x4*)(c.dst + (size_t)nn * c.ldd + c.k0 + k8 * 8) = o;
    }
  }
  __syncthreads();
}

DI void phase_init(const Params& p, char* smem) {
  if (blockIdx.x == 0 && threadIdx.x == 0) {
    float* lam = (float*)(p.ws + OFF_MISC + 64);
    for (int l = 0; l < 2; ++l) {
      const float* dl = p.diff_lambda + l * 256;
      float s01 = 0.f, s23 = 0.f;
      for (int i = 0; i < 64; ++i) { s01 += dl[i] * dl[64 + i]; s23 += dl[128 + i] * dl[192 + i]; }
      const float lam_init = 0.8f - 0.6f * expf(-0.3f * (float)l);
      lam[l] = expf(s01) - expf(s23) + lam_init;
    }
  }
  for (int it = blockIdx.x; it < 288; it += gridDim.x) modgemv_item(p, it, (float*)smem);
  for (int it = blockIdx.x; it < 1792; it += gridDim.x) convert_pair(p, 0, 4 * it, (float*)smem);
}

DI void rowpass(const Params& p, int l, int mode) {
  const int tid = opaque_tid();
  const int lane = tid & 63;
  const int wv = blockIdx.x * 8 + (tid >> 6), nw = gridDim.x * 8;
  const float* MOD = (const float*)(p.ws + OFF_MOD);
  const u16* T = (const u16*)(p.ws + OFF_T);
  u16* U = (u16*)(p.ws + OFF_U);
  float* HC = (float*)(p.ws + OFF_HC);
  int gpost = 0, gidx = 0, gpre = 0, sh = 0; float coef = 0.f;
  if (mode == 0) { gpre = 0; sh = 0; }
  else if (mode == 1) { gpost = 1; gidx = 2; coef = 0.5f; gpre = 2; sh = 3; }
  else if (mode == 2) { gpost = 3; gidx = 5; coef = 1.0f; gpre = 4; sh = 6; }
  else { gpost = 5; gidx = 8; coef = 0.5f; gpre = 0; sh = 0; }
  const int ln = (mode == 3) ? l + 1 : l;
  const bool has_u = ln < 2;
  const int nrows = (l == 1 && mode >= 2) ? ML : MT;
  for (int row = wv; row < nrows; row += nw) {
    const bool lat = row < ML;
    const int vi = lat ? (row >> 13) : 2;
    float* hp = lat ? p.out + (size_t)row * 1024 : HC + (size_t)(row - ML) * 1024;
    float4 h[4];
    if (mode == 0) {
      const float* sp = lat ? p.x + (size_t)row * 1024 : p.ctx + (size_t)(row - ML) * 1024;
#pragma unroll
      for (int i = 0; i < 4; ++i) { h[i] = *(const float4*)(sp + 4 * lane + 256 * i); *(float4*)(hp + 4 * lane + 256 * i) = h[i]; }
    } else {
      float4 t[4];
      const u16* tp = T + (size_t)row * 1024;
      float ss = 0.f;
#pragma unroll
      for (int i = 0; i < 4; ++i) {
        h[i] = *(const float4*)(hp + 4 * lane + 256 * i);
        const u32x2 tv = *(const u32x2*)(tp + 4 * lane + 256 * i);
        t[i] = make_float4(__uint_as_float(tv[0] << 16), __uint_as_float(tv[0] & 0xffff0000u),
                           __uint_as_float(tv[1] << 16), __uint_as_float(tv[1] & 0xffff0000u));
        ss += t[i].x * t[i].x + t[i].y * t[i].y + t[i].z * t[i].z + t[i].w * t[i].w;
      }
      ss = wave_sum(ss);
      const float rstd = rsqrtf(ss * (1.f / 1024.f) + EPSN) * coef;
      const float* gate = MOD + (size_t)(l * 3 + vi) * 9216 + gidx * 1024;
      const float* gp = p.norm_gain + (size_t)(l * 6 + gpost) * 1024;
#pragma unroll
      for (int i = 0; i < 4; ++i) {
        const float4 ga = *(const float4*)(gate + 4 * lane + 256 * i);
        const float4 gg = *(const float4*)(gp + 4 * lane + 256 * i);
        h[i].x += ga.x * (t[i].x * rstd * gg.x);
        h[i].y += ga.y * (t[i].y * rstd * gg.y);
        h[i].z += ga.z * (t[i].z * rstd * gg.z);
        h[i].w += ga.w * (t[i].w * rstd * gg.w);
        *(float4*)(hp + 4 * lane + 256 * i) = h[i];
      }
    }
    if (has_u) {
      float ss = 0.f;
#pragma unroll
      for (int i = 0; i < 4; ++i) ss += h[i].x * h[i].x + h[i].y * h[i].y + h[i].z * h[i].z + h[i].w * h[i].w;
      ss = wave_sum(ss);
      const float rstd = rsqrtf(ss * (1.f / 1024.f) + EPSN);
      const float* modn = MOD + (size_t)(ln * 3 + vi) * 9216;
      const float* gq = p.norm_gain + (size_t)(ln * 6 + gpre) * 1024;
#pragma unroll
      for (int i = 0; i < 4; ++i) {
        const int cidx = 4 * lane + 256 * i;
        const float4 gg = *(const float4*)(gq + cidx);
        const float4 sf = *(const float4*)(modn + sh * 1024 + cidx);
        const float4 sc = *(const float4*)(modn + (sh + 1) * 1024 + cidx);
        const float u0 = h[i].x * rstd * gg.x * (1.f + sc.x) + sf.x;
        const float u1 = h[i].y * rstd * gg.y * (1.f + sc.y) + sf.y;
        const float u2 = h[i].z * rstd * gg.z * (1.f + sc.z) + sf.z;
        const float u3 = h[i].w * rstd * gg.w * (1.f + sc.w) + sf.w;
        u32x2 o = {pack2(u0, u1), pack2(u2, u3)};
        *(u32x2*)(U + (size_t)row * 1024 + cidx) = o;
      }
    }
  }
}

#define LAS __attribute__((address_space(3)))
#define GLDS_SO(base_, voff_, l_) { const unsigned la_ = __builtin_amdgcn_readfirstlane((unsigned)(size_t)((LAS char*)(l_))); unsigned keep_; \
    asm volatile("s_mov_b32 %0, m0\n\ts_mov_b32 m0, %3\n\ts_nop 0\n\tglobal_load_lds_dwordx4 %1, %2\n\ts_mov_b32 m0, %0" \
                 : "=&s"(keep_) : "v"(voff_), "s"(base_), "s"(la_) : "memory"); }
DI void glds16(const void* g, char* l) {
  const unsigned la = __builtin_amdgcn_readfirstlane((unsigned)(size_t)((LAS char*)l));
  unsigned keep;
  asm volatile("s_mov_b32 %0, m0\n\ts_mov_b32 m0, %2\n\ts_nop 0\n\tglobal_load_lds_dwordx4 %1, off\n\ts_mov_b32 m0, %0"
               : "=&s"(keep) : "v"(g), "s"(la) : "memory");
}

template <int NBW, bool TR = false>
DI void gemm_mainloop(const u16* __restrict__ A, int lda, const u16* __restrict__ BT, int ldb, int K,
                      f32x16 (&acc)[4][NBW], char* smem, const int tid) {
  const int lane = tid & 63, w = tid >> 6;
  const int wm = w >> 2, wn = w & 3, h = lane >> 5, r31 = lane & 31;
  constexpr int BST = 16384 * NBW;
  char* sA = smem;
  char* sB = smem + 65536;
  const int lr = tid >> 3;
  const int lc = (tid & 7) ^ ((tid >> 4) & 7);
  const u16* ga = A + (size_t)lr * lda + lc * 8;
  const int lrb = TR ? ((lr & ~31) + 16 * ((lr >> 2) & 1) + (lr & 3) + 4 * ((lr & 31) >> 3)) : lr;
  const u16* gb = BT + (size_t)lrb * ldb + lc * 8;
  char* wA = sA + tid * 16;
  char* wB = sB + tid * 16;
  const int sx = (r31 >> 1) & 7;
  const int aoff = (wm * 128 + r31) * 128;
  const int boff = (wn * 32 * NBW + r31) * 128;
#pragma unroll
  for (int i = 0; i < 4; ++i) glds16(ga + (size_t)(64 * i) * lda, wA + i * 8192);
#pragma unroll
  for (int i = 0; i < 2 * NBW; ++i) glds16(gb + (size_t)(64 * i) * ldb, wB + i * 8192);
  asm volatile("s_waitcnt vmcnt(0)" ::: "memory");
  __syncthreads();
  const int nk = K >> 6;
  for (int kt = 0; kt < nk; ++kt) {
    const int cur = kt & 1;
    if (kt + 1 < nk) {
#pragma unroll
      for (int i = 0; i < 4; ++i) glds16(ga + (size_t)(64 * i) * lda + (kt + 1) * 64, wA + (cur ^ 1) * 32768 + i * 8192);
#pragma unroll
      for (int i = 0; i < 2 * NBW; ++i) glds16(gb + (size_t)(64 * i) * ldb + (kt + 1) * 64, wB + (cur ^ 1) * BST + i * 8192);
    }
    const char* cA = sA + cur * 32768;
    const char* cB = sB + cur * BST;
    bf16x8 aa[2][4], bb[2][NBW];
    {
      const int co = (h ^ sx) << 4;
#pragma unroll
      for (int mb = 0; mb < 4; ++mb) aa[0][mb] = *(const bf16x8*)(cA + aoff + mb * 4096 + co);
#pragma unroll
      for (int nb = 0; nb < NBW; ++nb) bb[0][nb] = *(const bf16x8*)(cB + boff + nb * 4096 + co);
    }
#pragma unroll
    for (int ks = 0; ks < 4; ++ks) {
      if (ks < 3) {
        const int co = ((2 * (ks + 1) + h) ^ sx) << 4;
#pragma unroll
        for (int mb = 0; mb < 4; ++mb) aa[(ks + 1) & 1][mb] = *(const bf16x8*)(cA + aoff + mb * 4096 + co);
#pragma unroll
        for (int nb = 0; nb < NBW; ++nb) bb[(ks + 1) & 1][nb] = *(const bf16x8*)(cB + boff + nb * 4096 + co);
      }
#pragma unroll
      for (int mb = 0; mb < 4; ++mb)
#pragma unroll
        for (int nb = 0; nb < NBW; ++nb)
          acc[mb][nb] = TR ? mfma32(bb[ks & 1][nb], aa[ks & 1][mb], acc[mb][nb]) : mfma32(aa[ks & 1][mb], bb[ks & 1][nb], acc[mb][nb]);
      __builtin_amdgcn_sched_barrier(0);
    }
    asm volatile("s_waitcnt vmcnt(0) lgkmcnt(0)" ::: "memory");
    __builtin_amdgcn_s_barrier();
    asm volatile("" ::: "memory");
  }
}

typedef float f32x4v __attribute__((ext_vector_type(4)));
DI f32x4v mfma16(bf16x8 a, bf16x8 b, f32x4v c) { return __builtin_amdgcn_mfma_f32_16x16x32_bf16(a, b, c, 0, 0, 0); }
DI void gemm_mainloop8(const u16* __restrict__ A, const u16* __restrict__ nA, int lda, const u16* __restrict__ BT, const u16* __restrict__ nBT, int ldb, int K,
                       f32x4v (&acc)[4][2][4], char* smem, const int tid_, const bool first, const bool last) {
  int tid = tid_;
  asm volatile("" : "+v"(tid));
  const int lane = tid & 63, w = tid >> 6;
  const int wr = w >> 2, wc = w & 3, h = lane >> 5, r31 = lane & 31;
  const int srow = tid >> 3;
  const int scol = ((tid & 7) ^ ((tid >> 4) & 7)) * 8;
  const unsigned oA = (unsigned)(srow * lda + scol) * 2u;
  const int rho = srow & 31;
  const int brow0 = (srow >> 5) * 64 + 8 * ((rho & 15) >> 2) + 4 * (rho >> 4) + (rho & 3);
  const unsigned oB = (unsigned)(brow0 * ldb + scol) * 2u;
  const unsigned ldaB = (unsigned)lda * 2u, ldbB = (unsigned)ldb * 2u;
  char* wdst = smem + __builtin_amdgcn_readfirstlane(w) * 1024;
  const int m16 = lane & 15, g4 = lane >> 4;
  const int sx = (m16 >> 1) & 7;
  const int aoff = (wr * 64 + m16) * 128;
  const int boff = (wc * 32 + m16) * 128;
#define SA_(b, hf) (smem + ((b) * 2 + (hf)) * 16384)
#define SB_(b, hf) (smem + 65536 + ((b) * 2 + (hf)) * 16384)
#define STAGE_A(b, hf, kt) { const bool nx_ = (kt) >= nt; const u16* pa_ = nx_ ? nA : A; \
    const unsigned o_ = oA + (unsigned)((hf) * 128) * ldaB + (unsigned)(nx_ ? (kt) - nt : (kt)) * 128u; char* d_ = wdst + ((b) * 2 + (hf)) * 16384; \
    GLDS_SO(pa_, o_, d_); const unsigned o2_ = o_ + 64u * ldaB; GLDS_SO(pa_, o2_, d_ + 8192); }
#define STAGE_B(b, hf, kt) { const bool nx_ = (kt) >= nt; const u16* pb_ = nx_ ? nBT : BT; \
    const unsigned o_ = oB + (unsigned)((hf) * 32) * ldbB + (unsigned)(nx_ ? (kt) - nt : (kt)) * 128u; char* d_ = wdst + 65536 + ((b) * 2 + (hf)) * 16384; \
    GLDS_SO(pb_, o_, d_); const unsigned o2_ = o_ + 128u * ldbB; GLDS_SO(pb_, o2_, d_ + 8192); }
#define LDA_(dst, b, hf) _Pragma("unroll") for (int mq_ = 0; mq_ < 4; ++mq_) _Pragma("unroll") for (int kk_ = 0; kk_ < 2; ++kk_) \
    dst[mq_][kk_] = *(const bf16x8*)(SA_(b, hf) + aoff + mq_ * 2048 + (((4 * kk_ + g4) ^ sx) << 4));
#define LDB_(dst, b, hf) _Pragma("unroll") for (int nq_ = 0; nq_ < 2; ++nq_) _Pragma("unroll") for (int kk_ = 0; kk_ < 2; ++kk_) \
    dst[nq_][kk_] = *(const bf16x8*)(SB_(b, hf) + boff + nq_ * 2048 + (((4 * kk_ + g4) ^ sx) << 4));
#define MMA_(ai, bj, At_, Bt_) { __builtin_amdgcn_s_setprio(1); \
    _Pragma("unroll") for (int mq_ = 0; mq_ < 4; ++mq_) _Pragma("unroll") for (int nq_ = 0; nq_ < 2; ++nq_) _Pragma("unroll") for (int kk_ = 0; kk_ < 2; ++kk_) \
      acc[(ai) * 2 + (mq_ >> 1)][bj][(mq_ & 1) * 2 + nq_] = mfma16(Bt_[nq_][kk_], At_[mq_][kk_], acc[(ai) * 2 + (mq_ >> 1)][bj][(mq_ & 1) * 2 + nq_]); \
    __builtin_amdgcn_s_setprio(0); }
#define WAIT_V(n) asm volatile("s_waitcnt vmcnt(" #n ")" ::: "memory")
#define WAIT_L(n) asm volatile("s_waitcnt lgkmcnt(" #n ")" ::: "memory")
#define BAR __builtin_amdgcn_s_barrier()
#define SCHED __builtin_amdgcn_sched_barrier(0)
  bf16x8 At[4][2], B0[2][2], B1[2][2];
  const int nt = K >> 6;
  if (first) {
    STAGE_B(0, 0, 0); STAGE_A(0, 0, 0);
    STAGE_B(0, 1, 0); STAGE_A(0, 1, 0);
    if (wr == 1) BAR;
    WAIT_V(4); BAR;
    STAGE_B(1, 0, 1); STAGE_A(1, 0, 1); STAGE_B(1, 1, 1);
    WAIT_V(6); BAR;
  }
  for (int t = 0; t < nt; t += 2) {
    LDB_(B0, 0, 0); SCHED; LDA_(At, 0, 0); STAGE_A(1, 1, t + 1);
    WAIT_L(8); BAR; WAIT_L(0); MMA_(0, 0, At, B0); BAR; SCHED;
    LDB_(B1, 0, 1); STAGE_B(0, 0, t + 2);
    BAR; WAIT_L(0); MMA_(0, 1, At, B1); BAR;
    LDA_(At, 0, 1); STAGE_A(0, 0, t + 2);
    BAR; WAIT_L(0); MMA_(1, 0, At, B0); BAR; SCHED;
    STAGE_B(0, 1, t + 2);
    WAIT_V(6); BAR; MMA_(1, 1, At, B1); BAR;
    LDB_(B0, 1, 0); SCHED; LDA_(At, 1, 0); STAGE_A(0, 1, t + 2);
    WAIT_L(8); BAR; WAIT_L(0); MMA_(0, 0, At, B0); BAR; SCHED;
    LDB_(B1, 1, 1); STAGE_B(1, 0, t + 3);
    BAR; WAIT_L(0); MMA_(0, 1, At, B1); BAR;
    LDA_(At, 1, 1); STAGE_A(1, 0, t + 3);
    BAR; WAIT_L(0); MMA_(1, 0, At, B0); BAR; SCHED;
    STAGE_B(1, 1, t + 3);
    WAIT_V(6); BAR; MMA_(1, 1, At, B1); BAR;
  }
  if (last) {
    WAIT_V(0);
    if (wr == 0) BAR;
    __syncthreads();
  }
#undef SA_
#undef SB_
#undef STAGE_A
#undef STAGE_B
#undef LDA_
#undef LDB_
#undef MMA_
#undef WAIT_V
#undef WAIT_L
#undef BAR
#undef SCHED
}

DI bool tile_at(int it, int ntm, int ntn, int& tm, int& tn) {
  const int nloc = gridDim.x >> 3;
  const int L = (it * 8 + (blockIdx.x & 7)) * nloc + (blockIdx.x >> 3);
  if (L >= ntm * ntn) return false;
  const int full = ntn >> 2, pw = ntm * 4;
  int pnl, within, wd;
  if (L < full * pw) { pnl = L / pw; within = L - pnl * pw; wd = 4; }
  else { pnl = full; within = L - full * pw; wd = ntn - full * 4; }
  tm = within / wd;
  tn = pnl * 4 + within - tm * wd;
  return true;
}

template <int RB, int RS>
DI void flush_tile(const char* smem, char* gout, size_t ld_bytes, const int tid_) {
  constexpr int CPR = RB / 16;
  constexpr int PT = 256 * CPR / 512;
  int tid = tid_;
  asm volatile("" : "+v"(tid));
  __syncthreads();
#pragma unroll
  for (int i = 0; i < PT; ++i) {
    const int q = i * 512 + tid;
    const int row = q / CPR, c = q % CPR;
    const u32x4 v = *(const u32x4*)(smem + row * RS + c * 16);
    *(u32x4*)(gout + (size_t)row * ld_bytes + c * 16) = v;
  }
  __syncthreads();
}

#define ZERO_ACC(a, NBW_) _Pragma("unroll") for (int _m = 0; _m < 4; ++_m) _Pragma("unroll") for (int _n = 0; _n < NBW_; ++_n) _Pragma("unroll") for (int _i = 0; _i < 16; ++_i) a[_m][_n][_i] = 0.f;

template <int EPI, int KK>
DI void gemm_phase(const Params& p, int l, const u16* __restrict__ A, const u16* __restrict__ BT, int ntm, int ntn, char* smem) {
  constexpr int lda = KK, ldb = KK, K = KK;
  const int tid = opaque_tid(), lane = tid & 63, w = tid >> 6;
  const int wm = w >> 2, wn = w & 3, h = lane >> 5, r31 = lane & 31;
#define ROWOFF(mb_) ((((mb_) >> 1) * 128) + (((mb_) & 1) * 32))
  const bool split_ctx = (EPI == 0) && (ntm == MT / 256) && (gridDim.x >= 16);
  if (split_ctx) ntm = ML / 256;
  const int lrow0 = wm * 128 + 4 * h;
  bool first = true;
  for (int it = 0;; ++it) {
    int tm, tn;
    if (!tile_at(it, ntm, ntn, tm, tn)) break;
    const int m0 = tm * 256, n0 = tn * 256;
    const u16* cA = A + (size_t)m0 * lda;
    const u16* cB = BT + (size_t)n0 * ldb;
    const u16* nA = cA; const u16* nB = cB;
    bool last = true;
    {
      int tm2, tn2;
      if (tile_at(it + 1, ntm, ntn, tm2, tn2)) { nA = A + (size_t)tm2 * 256 * lda; nB = BT + (size_t)tn2 * 256 * ldb; last = false; }
    }
    f32x4v acc[4][2][4];
#pragma unroll
    for (int a_ = 0; a_ < 4; ++a_)
#pragma unroll
      for (int b_ = 0; b_ < 2; ++b_)
#pragma unroll
        for (int q_ = 0; q_ < 4; ++q_) acc[a_][b_][q_] = f32x4v{0.f, 0.f, 0.f, 0.f};
    gemm_mainloop8(cA, nA, lda, cB, nB, ldb, K, acc, smem, tid, first, last);
    first = false;
    int te = tid;
    asm volatile("" : "+v"(te));
    const int lane = te & 63, w = te >> 6, wm = w >> 2, wn = w & 3, m16 = lane & 15, g = lane >> 4;
    const int lrow = wm * 64 + m16;
    const int c0 = n0 + wn * 64;
#define PACK8(q0_, q1_) u32x4{pack2((q0_)[0], (q0_)[1]), pack2((q0_)[2], (q0_)[3]), pack2((q1_)[0], (q1_)[1]), pack2((q1_)[2], (q1_)[3])}
    if (EPI == 0) {
      char* gout = p.ws + OFF_T + ((size_t)(m0 + lrow) * 1024 + c0 + 8 * g) * 2;
#pragma unroll
      for (int mbx = 0; mbx < 4; ++mbx)
#pragma unroll
        for (int nb = 0; nb < 2; ++nb)
#pragma unroll
          for (int mblk = 0; mblk < 2; ++mblk)
            *(u32x4*)(gout + (size_t)(ROWOFF(mbx) + mblk * 16) * 2048 + nb * 64) = PACK8(acc[mbx][nb][mblk * 2], acc[mbx][nb][mblk * 2 + 1]);
    } else if (EPI == 1) {
      char* gout = p.ws + OFF_P + ((size_t)(m0 + lrow) * DFF + (n0 >> 1) + wn * 32 + 8 * g) * 2;
#pragma unroll
      for (int mbx = 0; mbx < 4; ++mbx)
#pragma unroll
        for (int mblk = 0; mblk < 2; ++mblk) {
          f32x4v o[2];
#pragma unroll
          for (int nblk = 0; nblk < 2; ++nblk)
#pragma unroll
            for (int r = 0; r < 4; ++r) {
              const float gt = acc[mbx][0][mblk * 2 + nblk][r], up = acc[mbx][1][mblk * 2 + nblk][r];
              o[nblk][r] = gt * __builtin_amdgcn_rcpf(1.f + __expf(-gt)) * up;
            }
          *(u32x4*)(gout + (size_t)(ROWOFF(mbx) + mblk * 16) * (DFF * 2)) = PACK8(o[0], o[1]);
        }
    } else if (EPI == 2) {
      char* gout = p.ws + OFF_P + ((size_t)(m0 + lrow) * NGATE + c0 + 8 * g) * 2;
#pragma unroll
      for (int mbx = 0; mbx < 4; ++mbx)
#pragma unroll
        for (int nb = 0; nb < 2; ++nb)
#pragma unroll
          for (int mblk = 0; mblk < 2; ++mblk) {
            f32x4v o[2];
#pragma unroll
            for (int nblk = 0; nblk < 2; ++nblk)
#pragma unroll
              for (int r = 0; r < 4; ++r) o[nblk][r] = __builtin_amdgcn_rcpf(1.f + __expf(-acc[mbx][nb][mblk * 2 + nblk][r]));
            *(u32x4*)(gout + (size_t)(ROWOFF(mbx) + mblk * 16) * (NGATE * 2) + nb * 64) = PACK8(o[0], o[1]);
          }
    } else {
      const int unit = c0 >> 6;
      bool rope = false, scale = false; int norm = -1;
      if (unit < 8) { rope = true; scale = true; }
      else if (unit < 16) { rope = true; }
      else if (unit < 24) { }
      else if (unit < 32) { scale = true; }
      else if (unit < 48) { }
      else if (unit < 56) { norm = 0; rope = true; scale = true; }
      else if (unit < 58) { norm = 1; rope = true; }
      else if (unit < 60) { }
      else if (unit < 68) { rope = true; scale = true; }
      else if (unit < 70) { rope = true; }
      const float qs = scale ? 0.125f * LOG2E : 1.f;
      const int axis = g >> 1, fb = (g & 1) * 8;
      const float fscale = exp2f(-(float)fb * (13.287712379549449f / 16.f));
      char* gout = p.ws + OFF_P + ((size_t)(m0 + lrow) * NQKV + c0 + 8 * g) * 2;
#pragma unroll
      for (int mbx = 0; mbx < 4; ++mbx)
#pragma unroll
        for (int mblk = 0; mblk < 2; ++mblk) {
          f32x4v x1[2] = {acc[mbx][0][mblk * 2], acc[mbx][0][mblk * 2 + 1]};
          f32x4v x2[2] = {acc[mbx][1][mblk * 2], acc[mbx][1][mblk * 2 + 1]};
          if (norm >= 0) {
            const float* gain = p.qk_norm + (size_t)(l * 2 + norm) * 64 + axis * 32 + fb;
            float ss = 0.f;
#pragma unroll
            for (int nblk = 0; nblk < 2; ++nblk)
#pragma unroll
              for (int r = 0; r < 4; ++r) ss += x1[nblk][r] * x1[nblk][r] + x2[nblk][r] * x2[nblk][r];
            ss += __shfl_xor(ss, 16);
            ss += __shfl_xor(ss, 32);
            const float rstd = rsqrtf(ss * (1.f / 64.f) + EPSN);
#pragma unroll
            for (int nblk = 0; nblk < 2; ++nblk)
#pragma unroll
              for (int r = 0; r < 4; ++r) { x1[nblk][r] *= rstd * gain[nblk * 4 + r]; x2[nblk][r] *= rstd * gain[16 + nblk * 4 + r]; }
          }
          if (rope) {
            const int row = m0 + ROWOFF(mbx) + mblk * 16 + lrow;
            const bool lat = row < ML;
            const int t = row & 8191;
            const float pos = (float)(axis ? (t & 63) : (t >> 6)) * fscale;
#pragma unroll
            for (int nblk = 0; nblk < 2; ++nblk)
#pragma unroll
              for (int r = 0; r < 4; ++r) {
                const float ang = pos * exp2f(-(float)(nblk * 4 + r) * (13.287712379549449f / 16.f));
                const float cs = lat ? __cosf(ang) : 1.f, sn = lat ? __sinf(ang) : 0.f;
                const float a1 = x1[nblk][r], a2 = x2[nblk][r];
                x1[nblk][r] = a1 * cs - a2 * sn;
                x2[nblk][r] = a2 * cs + a1 * sn;
              }
          }
#pragma unroll
          for (int nblk = 0; nblk < 2; ++nblk)
#pragma unroll
            for (int r = 0; r < 4; ++r) { x1[nblk][r] *= qs; x2[nblk][r] *= qs; }
          char* gp = gout + (size_t)(ROWOFF(mbx) + mblk * 16) * (NQKV * 2);
          *(u32x4*)gp = PACK8(x1[0], x1[1]);
          *(u32x4*)(gp + 64) = PACK8(x2[0], x2[1]);
        }
    }
#undef PACK8
  }
  if (EPI == 0) {
    if (split_ctx && blockIdx.x < 16) {
      const int m0 = ML + (blockIdx.x >> 3) * 256, n0 = (blockIdx.x & 7) * 128;
      f32x16 acc1[4][1];
      ZERO_ACC(acc1, 1);
      gemm_mainloop<1>(A + (size_t)m0 * lda, lda, BT + (size_t)n0 * ldb, ldb, K, acc1, smem, tid);
#pragma unroll
      for (int mb = 0; mb < 4; ++mb)
#pragma unroll
        for (int i = 0; i < 16; ++i) {
          const int lrow = lrow0 + mb * 32 + (i & 3) + 8 * (i >> 2);
          *(u16*)(smem + lrow * 272 + (wn * 32 + r31) * 2) = f2bf(acc1[mb][0][i]);
        }
      flush_tile<256, 272>(smem, p.ws + OFF_T + ((size_t)m0 * 1024 + n0) * 2, 1024 * 2, tid);
    }
  }
}

DI void branch_phase(const Params& p, int ntm, char* smem) {
  const int tid = opaque_tid();
  const u16* YS = (const u16*)(p.ws + OFF_T);
  const u16* WB = (const u16*)(p.ws + OFF_WB);
  const u16* G = (const u16*)(p.ws + OFF_P);
  u16* ACC = (u16*)(p.ws + OFF_U);
  for (int it = 0;; ++it) {
    int tm, tn;
    if (!tile_at(it, ntm, 8, tm, tn)) break;
    const int m0 = tm * 256, n0 = tn * 128;
    f32x16 tot[4];
#pragma unroll
    for (int mb = 0; mb < 4; ++mb)
#pragma unroll
      for (int i = 0; i < 16; ++i) tot[mb][i] = 0.f;
    for (int br = 0; br < 4; ++br) {
      int te = tid;
      asm volatile("" : "+v"(te));
      const int lane = te & 63, w = te >> 6, wm = w >> 2, wn = w & 3, h = lane >> 5, r31 = lane & 31;
      const u16* gp = G + (size_t)(m0 + wm * 128 + r31) * NGATE + br * 1024 + n0 + wn * 32 + 16 * h;
      u32x4 gq[4][2];
#pragma unroll
      for (int mb = 0; mb < 4; ++mb) {
        gq[mb][0] = *(const u32x4*)(gp + (size_t)(mb * 32) * NGATE);
        gq[mb][1] = *(const u32x4*)(gp + (size_t)(mb * 32) * NGATE + 8);
      }
      f32x16 acc[4][1];
      ZERO_ACC(acc, 1);
      gemm_mainloop<1, true>(YS + (size_t)m0 * 2048 + br * 512, 2048, WB + (size_t)br * 1024 * 512 + (size_t)n0 * 512, 512, 512, acc, smem, tid);
#pragma unroll
      for (int mb = 0; mb < 4; ++mb)
#pragma unroll
        for (int j = 0; j < 8; ++j) {
          const unsigned u = j < 4 ? gq[mb][0][j & 3] : gq[mb][1][j & 3];
          tot[mb][2 * j] += __uint_as_float(u << 16) * acc[mb][0][2 * j];
          tot[mb][2 * j + 1] += __uint_as_float(u & 0xffff0000u) * acc[mb][0][2 * j + 1];
        }
    }
    {
      int te = tid;
      asm volatile("" : "+v"(te));
      const int lane = te & 63, w = te >> 6, wm = w >> 2, wn = w & 3, h = lane >> 5, r31 = lane & 31;
      u16* op = ACC + (size_t)(m0 + wm * 128 + r31) * 1024 + n0 + wn * 32 + 16 * h;
#pragma unroll
      for (int mb = 0; mb < 4; ++mb) {
        u32x4 lo, hi;
#pragma unroll
        for (int j = 0; j < 4; ++j) { lo[j] = pack2(tot[mb][2 * j], tot[mb][2 * j + 1]); hi[j] = pack2(tot[mb][8 + 2 * j], tot[mb][9 + 2 * j]); }
        *(u32x4*)(op + (size_t)(mb * 32) * 1024) = lo;
        *(u32x4*)(op + (size_t)(mb * 32) * 1024 + 8) = hi;
      }
    }
  }
}

DI s16x4 tr_read(const char* a) {
  return __builtin_amdgcn_ds_read_tr16_b64_v4i16((s16x4 __attribute__((address_space(3)))*)(a));
}

template <int DV>
DI void attn_pass(const u16* __restrict__ P, int mode, int qrow0, int qcol, int kcol, int vcol,
                  int lat_row0, int nlat, int ctx_row0, int mq0, int mq1, int krlo,
                  const float* __restrict__ nab, float sink_l2, bool has_sink,
                  f32x16 (&O)[DV / 32], char* smem, const int tid) {
  constexpr int NDB = DV / 32;
  constexpr int VBUF = NDB * 4096;
  const int lane = tid & 63, w = tid >> 6, h = lane >> 5, r31 = lane & 31;
  char* sK = smem;
  char* sV = smem + 16384;
  float* sbias = (float*)(smem + 65536);

  bf16x8 qf[4];
  {
    const u16* qp = P + (size_t)(qrow0 + w * 32 + r31) * NQKV + qcol + 8 * h;
#pragma unroll
    for (int ks = 0; ks < 4; ++ks) qf[ks] = *(const bf16x8*)(qp + 16 * ks);
  }
  const u16* kbase = P + (size_t)(tid >> 3) * NQKV + kcol + ((tid & 7) ^ ((tid >> 4) & 7)) * 8;
  const u16* vbase = P + (size_t)((tid >> 2) & 63) * NQKV + vcol + ((tid >> 8) * 4 + (tid & 3)) * 8;
  char* wK = sK + tid * 16;
  char* wV = sV + tid * 16;
  const int nt = nlat + 4;

#define ATT_LOADK(t_, buf_)                                                                   \
  {                                                                                           \
    const int r0_ = (t_) < nlat ? lat_row0 + (t_) * 64 : ctx_row0 + ((t_) - nlat) * 64;       \
    const u16* kp_ = kbase + (size_t)r0_ * NQKV;                                              \
    glds16(kp_, wK + (buf_) * 8192);                                                          \
  }
#define ATT_LOADV(t_, buf_)                                                                   \
  {                                                                                           \
    const int r0_ = (t_) < nlat ? lat_row0 + (t_) * 64 : ctx_row0 + ((t_) - nlat) * 64;       \
    const u16* vp_ = vbase + (size_t)r0_ * NQKV;                                              \
    _Pragma("unroll") for (int i_ = 0; i_ < NDB / 2; ++i_) glds16(vp_ + i_ * 64, wV + (buf_) * VBUF + i_ * 8192); \
  }

  float m = -1e30f, lsum = 0.f;
#pragma unroll
  for (int db = 0; db < NDB; ++db)
#pragma unroll
    for (int i = 0; i < 16; ++i) O[db][i] = 0.f;

  const int sx = (r31 >> 1) & 7;
  const int i16 = lane & 15;
  const int troff = (4 * h + (i16 >> 2)) * 64 + 8 * (4 * ((lane >> 4) & 1) + (i16 & 3));
  const int na_rs = clampi(mq0 - 4, 0, 120);
  const int na_cs = clampi(mq1 - 8, 0, 48);
  const int koff = r31 * 128;

  auto qk = [&](f32x16 (&s)[2], const char* cK) __attribute__((always_inline)) {
    bf16x8 kf[2][4];
#pragma unroll
    for (int kb = 0; kb < 2; ++kb)
#pragma unroll
      for (int ks = 0; ks < 4; ++ks) kf[kb][ks] = *(const bf16x8*)(cK + kb * 4096 + koff + (((2 * ks + h) ^ sx) << 4));
#pragma unroll
    for (int kb = 0; kb < 2; ++kb) {
#pragma unroll
      for (int i = 0; i < 16; ++i) s[kb][i] = 0.f;
#pragma unroll
      for (int ks = 0; ks < 4; ++ks) s[kb] = mfma32(kf[kb][ks], qf[ks], s[kb]);
    }
  };
  auto process = [&](f32x16 (&s)[2], const char* cV, int t) __attribute__((always_inline)) {
    const bool masked = (mode != 0) && (t < nlat);
    if (masked) {
      if (mode == 1) {
        const int kp0 = mq1 + t * 64 + 4 * h - mq0;
#pragma unroll
        for (int kb = 0; kb < 2; ++kb)
#pragma unroll
          for (int i = 0; i < 16; ++i) {
            const int d = kp0 + kb * 32 + (i & 3) + 8 * (i >> 2);
            if (d > 128 || d < -128) s[kb][i] = -1e30f;
          }
      } else {
        const int krow = krlo + t;
        const float* nb = sbias + (krow - mq0 + 7) * 31 + 15 - mq1;
#pragma unroll
        for (int kb = 0; kb < 2; ++kb)
#pragma unroll
          for (int i = 0; i < 16; ++i) {
            const int kcx = kb * 32 + (i & 3) + 8 * (i >> 2) + 4 * h;
            const bool ok = (kcx >= na_cs) && (kcx < na_cs + 16);
            const float bias = nb[ok ? kcx : na_cs];
            s[kb][i] = ok ? s[kb][i] + bias : -1e30f;
          }
      }
    }
    float mx = s[0][0];
#pragma unroll
    for (int kb = 0; kb < 2; ++kb)
#pragma unroll
      for (int i = 0; i < 16; ++i) mx = fmaxf(mx, s[kb][i]);
    mx = fmaxf(mx, __shfl_xor(mx, 32));
    if (__any(mx > m + 8.f)) {
      const float mn = fmaxf(m, mx);
      const float alpha = fexp2(m - mn);
      m = mn;
      lsum *= alpha;
#pragma unroll
      for (int db = 0; db < NDB; ++db)
#pragma unroll
        for (int i = 0; i < 16; ++i) O[db][i] *= alpha;
    }
    float ps = 0.f;
#pragma unroll
    for (int kb = 0; kb < 2; ++kb)
#pragma unroll
      for (int i = 0; i < 16; ++i) { const float pv = fexp2(s[kb][i] - m); s[kb][i] = pv; ps += pv; }
    lsum += ps;
    bf16x8 pf[2][2];
#pragma unroll
    for (int kb = 0; kb < 2; ++kb)
#pragma unroll
      for (int s2 = 0; s2 < 2; ++s2) {
        u32x4 u;
#pragma unroll
        for (int jj = 0; jj < 4; ++jj) u[jj] = pack2(s[kb][8 * s2 + 2 * jj], s[kb][8 * s2 + 2 * jj + 1]);
        pf[kb][s2] = __builtin_bit_cast(bf16x8, u);
      }
    constexpr int NF = NDB * 4;
    s16x4 vlo[4], vhi[4];
#pragma unroll
    for (int f = 0; f < 4; ++f) {
      const char* a = cV + (f >> 2) * 4096 + (((f >> 1) & 1) * 32 + 16 * (f & 1)) * 64 + troff;
      vlo[f] = tr_read(a);
      vhi[f] = tr_read(a + 8 * 64);
    }
#pragma unroll
    for (int f = 0; f < NF; ++f) {
      const bf16x8 vf = __builtin_shufflevector(vlo[f & 3], vhi[f & 3], 0, 1, 2, 3, 4, 5, 6, 7);
      if (f + 4 < NF) {
        const int g = f + 4;
        const char* a = cV + (g >> 2) * 4096 + (((g >> 1) & 1) * 32 + 16 * (g & 1)) * 64 + troff;
        vlo[f & 3] = tr_read(a);
        vhi[f & 3] = tr_read(a + 8 * 64);
      }
      O[f >> 2] = mfma32(vf, pf[(f >> 1) & 1][f & 1], O[f >> 2]);
    }
  };
  auto step = [&](f32x16 (&sc)[2], f32x16 (&sn)[2], int t) __attribute__((always_inline)) {
    const int cur = t & 1;
    if (t + 2 < nt) ATT_LOADK(t + 2, cur);
    if (t + 1 < nt) {
      ATT_LOADV(t + 1, cur ^ 1);
      qk(sn, sK + (cur ^ 1) * 8192);
    }
    bool active = true;
    if (mode == 2 && t < nlat) { const int krow = krlo + t; active = (krow >= na_rs) && (krow < na_rs + 8); }
    if (active) process(sc, sV + cur * VBUF, t);
    asm volatile("s_waitcnt vmcnt(0) lgkmcnt(0)" ::: "memory");
    __builtin_amdgcn_s_barrier();
    asm volatile("" ::: "memory");
  };

  ATT_LOADK(0, 0);
  ATT_LOADV(0, 0);
  ATT_LOADK(1, 1);
  if (mode == 2) {
    for (int i = tid; i < 15 * 31; i += 512) sbias[i] = nab[i] * LOG2E;
  }
  asm volatile("s_waitcnt vmcnt(0)" ::: "memory");
  __syncthreads();
  f32x16 sa[2], sb[2];
  qk(sa, sK);
  __syncthreads();
  for (int t = 0; t < nt; t += 2) {
    step(sa, sb, t);
    if (t + 1 < nt) step(sb, sa, t + 1);
  }
  float lt = lsum + __shfl_xor(lsum, 32);
  if (has_sink) lt += fexp2(sink_l2 - m);
  const float inv = 1.f / lt;
#pragma unroll
  for (int db = 0; db < NDB; ++db)
#pragma unroll
    for (int i = 0; i < 16; ++i) O[db][i] *= inv;
#undef ATT_LOADK
#undef ATT_LOADV
}

template <int NDB>
DI void store_ys(u16* __restrict__ YS, int row, int col, const f32x16 (&O)[NDB], int h) {
#pragma unroll
  for (int db = 0; db < NDB; ++db)
#pragma unroll
    for (int g = 0; g < 4; ++g) {
      u32x2 o = {pack2(O[db][4 * g], O[db][4 * g + 1]), pack2(O[db][4 * g + 2], O[db][4 * g + 3])};
      *(u32x2*)(YS + (size_t)row * 2048 + col + db * 32 + 8 * g + 4 * h) = o;
    }
}

DI void attn_phase(const Params& p, int l, int rep, char* smem) {
  __shared__ int s_item;
  const int tid = opaque_tid(), lane = tid & 63, w = tid >> 6, h = lane >> 5, r31 = lane & 31;
  const int nitems = (l == 0) ? 1848 : 1792;
  int* counter = (int*)(p.ws + OFF_BAR) + l + 2 * rep;
  const u16* P = (const u16*)(p.ws + OFF_P);
  u16* YS = (u16*)(p.ws + OFF_T);
  const float lam = ((const float*)(p.ws + OFF_MISC + 64))[l];
  const float lam_init = 0.8f - 0.6f * expf(-0.3f * (float)l);
  float* stash = (float*)(p.ws + OFF_STASH + (size_t)blockIdx.x * 131072);
  for (;;) {
    if (tid == 0) s_item = atomicAdd(counter, 1);
    __syncthreads();
    const int item = s_item;
    __syncthreads();
    if (item >= nitems) break;
    int type, b, hd, qb; bool isctx = false;
    if (item < 256) { type = 0; b = item >> 7; hd = (item >> 5) & 3; qb = item & 31; }
    else if (item < 1792) {
      const int j = (item - 256) & 511;
      const int seg = (item - 256) >> 9;
      type = seg == 0 ? 2 : (seg == 1 ? 3 : 1);
      b = j >> 8; hd = (j >> 5) & 7; qb = j & 31;
    } else {
      isctx = true; qb = 0;
      int j = item - 1792;
      if (j < 8) { type = 0; b = j >> 2; hd = j & 3; }
      else { j -= 8; const int seg = j >> 4; j &= 15; type = seg + 1; b = j >> 3; hd = j & 7; }
    }
    const int ctx_row0 = ML + b * 256;
    const int qrow0 = isctx ? ctx_row0 : b * 8192 + qb * 256;
    const int row = qrow0 + w * 32 + r31;
    if (type == 0) {
      f32x16 O[4];
      for (int pass = 0; pass < 2; ++pass) {
        attn_pass<128>(P, 0, qrow0, hd * 128 + pass * 64, 512 + hd * 128 + pass * 64, 1024 + hd * 128,
                       b * 8192, isctx ? 0 : 128, ctx_row0, 0, 0, 0, nullptr, 0.f, false, O, smem, tid);
        if (pass == 0) {
          float4* st = (float4*)(stash + tid * 64);
#pragma unroll
          for (int db = 0; db < 4; ++db)
#pragma unroll
            for (int g = 0; g < 4; ++g) st[db * 4 + g] = make_float4(O[db][4 * g], O[db][4 * g + 1], O[db][4 * g + 2], O[db][4 * g + 3]);
        }
      }
      float ss = 0.f;
      const float4* st = (const float4*)(stash + tid * 64);
#pragma unroll
      for (int db = 0; db < 4; ++db)
#pragma unroll
        for (int g = 0; g < 4; ++g) {
          const float4 sv = st[db * 4 + g];
          const float d0 = sv.x - lam * O[db][4 * g], d1 = sv.y - lam * O[db][4 * g + 1];
          const float d2 = sv.z - lam * O[db][4 * g + 2], d3 = sv.w - lam * O[db][4 * g + 3];
          O[db][4 * g] = d0; O[db][4 * g + 1] = d1; O[db][4 * g + 2] = d2; O[db][4 * g + 3] = d3;
          ss += d0 * d0 + d1 * d1 + d2 * d2 + d3 * d3;
        }
      ss += __shfl_xor(ss, 32);
      const float rstd = rsqrtf(ss * (1.f / 128.f) + EPSN) * (1.f - lam_init);
      const float* sub = p.diff_subln + l * 128;
#pragma unroll
      for (int db = 0; db < 4; ++db)
#pragma unroll
        for (int i = 0; i < 16; ++i) O[db][i] *= rstd * sub[db * 32 + (i & 3) + 8 * (i >> 2) + 4 * h];
      store_ys<4>(YS, row, hd * 128, O, h);
    } else {
      f32x16 O[2];
      int mode = 0, qcol, kcol, vcol, lat_row0 = b * 8192, nlat = isctx ? 0 : 128, mq0 = 0, mq1 = 0, krlo = 0, outcol;
      float sink_l2 = 0.f; bool has_sink = false;
      if (type == 1) {
        const int r0 = 4 * qb;
        krlo = clampi(r0 - 4, 0, 120);
        const int krhi = clampi(r0 - 1, 0, 120) + 7;
        if (!isctx) { mode = 2; nlat = krhi - krlo + 1; lat_row0 = b * 8192 + krlo * 64; }
        mq0 = r0 + (w >> 1); mq1 = (w & 1) * 32 + r31;
        qcol = 1536 + hd * 64; kcol = 2048 + hd * 64; vcol = 2560 + hd * 64; outcol = 512 + hd * 64;
      } else if (type == 2) {
        qcol = 3072 + hd * 64; kcol = 3584 + (hd >> 2) * 64; vcol = 3712 + (hd >> 2) * 64; outcol = 1024 + hd * 64;
      } else {
        const int start = qb > 0 ? qb * 256 - 128 : 0;
        const int end = qb < 31 ? qb * 256 + 384 : 8192;
        if (!isctx) { mode = 1; nlat = (end - start) >> 6; lat_row0 = b * 8192 + start; }
        mq0 = qb * 256 + w * 32 + r31; mq1 = start;
        sink_l2 = p.sink[l * 8 + hd] * LOG2E; has_sink = true;
        qcol = 3840 + hd * 64; kcol = 4352 + (hd >> 2) * 64; vcol = 4480 + (hd >> 2) * 64; outcol = 1536 + hd * 64;
      }
      attn_pass<64>(P, mode, qrow0, qcol, kcol, vcol, lat_row0, nlat, ctx_row0, mq0, mq1, krlo,
                    p.na_bias + (size_t)(l * 8 + hd) * 15 * 31, sink_l2, has_sink, O, smem, tid);
      store_ys<2>(YS, row, outcol, O, h);
    }
  }
}


#define XB_TMO      128
#define XB_XCNT(j)  (256  + 64 * (j))
#define XB_XSUB(j)  (1280 + 64 * (j))
#define XB_XGEN(j)  (2304 + 64 * (j))
#define XB_TOP      3328
#define XB_TOPGEN   3392
#define XCD_BAR_WORDS 3456
#define XB_SPIN_CAP (1u << 22)
DI unsigned xb_ld(unsigned* q) { return __hip_atomic_load(q, __ATOMIC_RELAXED, __HIP_MEMORY_SCOPE_AGENT); }
DI unsigned xb_add(unsigned* q, unsigned v) { return __hip_atomic_fetch_add(q, v, __ATOMIC_RELAXED, __HIP_MEMORY_SCOPE_AGENT); }
DI unsigned xb_xcc_id() { return (unsigned)__builtin_amdgcn_s_getreg((3 << 11) | 20) & 0xFu; }
#define XB_SPIN(cond, bar) do { unsigned _sp = 0; while (cond) { __builtin_amdgcn_s_sleep(1); \
    if ((++_sp & 255u) == 0u) { if (xb_ld(&(bar)[XB_TMO])) break; if (_sp > XB_SPIN_CAP) { atomicAdd(&(bar)[XB_TMO], 1u); break; } } } } while (0)
struct XcdBarrier { unsigned* bar; unsigned x; volatile LAS unsigned* st; };
DI XcdBarrier xcd_barrier_post(unsigned* bar, volatile LAS unsigned* st) {
  XcdBarrier b; b.bar = bar; b.x = xb_xcc_id(); b.st = st;
  if (threadIdx.x == 0) (void)xb_add(&bar[XB_XCNT(b.x)], 1u);
  return b;
}
DI void xcd_barrier_complete(unsigned* bar, unsigned x, unsigned& nloc, unsigned& nx) {
  const unsigned G = gridDim.x * gridDim.y * gridDim.z;
  unsigned sum, cnt, mine, sp = 0u;
  for (;;) {
    sum = 0u; cnt = 0u; mine = 0u;
#pragma unroll
    for (unsigned j = 0; j < 16; ++j) { const unsigned c = xb_ld(&bar[XB_XCNT(j)]); sum += c; cnt += (c > 0u) ? 1u : 0u; mine = (j == x) ? c : mine; }
    if (sum == G) break;
    __builtin_amdgcn_s_sleep(1);
    if ((++sp & 255u) == 0u) { if (xb_ld(&bar[XB_TMO])) break; if (sp > XB_SPIN_CAP) { atomicAdd(&bar[XB_TMO], 1u); break; } }
  }
  nloc = mine > 0u ? mine : 1u; nx = cnt > 0u ? cnt : 1u;
}
DI void xcd_barrier(const XcdBarrier& b) {
  asm volatile("s_waitcnt vmcnt(0)" ::: "memory");
  __syncthreads();
  if (threadIdx.x == 0) {
    unsigned* bar = b.bar;
    __builtin_amdgcn_s_waitcnt(0);
    unsigned nloc = b.st[0], nx = b.st[1];
    if (nloc == 0u) { xcd_barrier_complete(bar, b.x, nloc, nx); b.st[0] = nloc; b.st[1] = nx; }
    const unsigned old = xb_add(&bar[XB_XSUB(b.x)], 1u);
    const unsigned gen = old / nloc;
    if (old + 1u == (gen + 1u) * nloc) {
      __builtin_amdgcn_fence(__ATOMIC_RELEASE, "agent");
      asm volatile("s_waitcnt vmcnt(0)" ::: "memory");
      const unsigned og = xb_add(&bar[XB_TOP], 1u);
      const unsigned tg = og / nx;
      if (og + 1u == (tg + 1u) * nx) xb_add(&bar[XB_TOPGEN], 1u);
      else XB_SPIN(xb_ld(&bar[XB_TOPGEN]) == tg, bar);
      __builtin_amdgcn_fence(__ATOMIC_ACQUIRE, "agent");
      xb_add(&bar[XB_XGEN(b.x)], 1u);
      asm volatile("s_waitcnt vmcnt(0)" ::: "memory");
    } else {
      XB_SPIN(xb_ld(&bar[XB_XGEN(b.x)]) == gen, bar);
      __builtin_amdgcn_fence(__ATOMIC_ACQUIRE, "agent");
      asm volatile("s_waitcnt vmcnt(0)" ::: "memory");
    }
  }
  __syncthreads();
}

__global__ void __launch_bounds__(512, 2) mk_forward(Params p) {
  __shared__ __attribute__((aligned(16))) char smem[135168];
  __shared__ uint4 xb_words;
  cg::grid_group grid = cg::this_grid();
  if (threadIdx.x == 0) xb_words = make_uint4(0u, 0u, 0u, 0u);
  __syncthreads();
  XcdBarrier xb = xcd_barrier_post((unsigned*)(p.ws + OFF_BAR), (volatile LAS unsigned*)&xb_words);
#if MK_MULTI
  const int ph_lo = p.phase_lo, ph_hi = p.phase_hi; const bool coop = false;
#else
  constexpr int ph_lo = 0, ph_hi = NPHASE; constexpr bool coop = true;
#endif
  for (int ph = ph_lo; ph < ph_hi; ++ph) {
    char* ws = opaque_ws(p.ws);
    const u16* U = (const u16*)(ws + OFF_U);
    const u16* PB = (const u16*)(ws + OFF_P);
    if (ph == 0) { for (int rep = 0; rep < REP_INIT; ++rep) phase_init(p, smem); }
    else {
      const int l = ph == 1 ? 0 : (ph - 2) / 12, s = ph == 1 ? 12 : (ph - 2) % 12;
      int epi = -1, lda = 1024, ldb = 1024, K = 1024, ntn = 4;
      const u16* A = U; const u16* BT = nullptr;
      switch (s) {
        case 0: epi = 1; BT = (const u16*)(ws + OFF_WGU1); ntn = 22; break;
        case 1: epi = 0; A = PB; lda = DFF; BT = (const u16*)(ws + OFF_WD1); ldb = DFF; K = DFF; break;
        case 3: epi = 3; BT = (const u16*)(ws + OFF_WIN); ntn = 18; break;
        case 5: epi = 2; BT = (const u16*)(ws + OFF_WIN) + (size_t)NQKV * 1024; ntn = 16; break;
        case 7: epi = 0; BT = (const u16*)(ws + OFF_WOUT); break;
        case 9: epi = 1; BT = (const u16*)(ws + OFF_WGU2); ntn = 22; break;
        case 10: epi = 0; A = PB; lda = DFF; BT = (const u16*)(ws + OFF_WD2); ldb = DFF; K = DFF; break;
        default: break;
      }
      if (epi >= 0 || s == 6) {
        for (int rep = 0; rep < REP_GEMM; ++rep) {
          const int ntm = (l == 1 && s >= 5) ? ML / 256 : MT / 256;
          if (epi == 0) { if (K == DFF) gemm_phase<0, DFF>(p, l, A, BT, ntm, ntn, smem); else gemm_phase<0, 1024>(p, l, A, BT, ntm, ntn, smem); }
          else if (epi == 1) gemm_phase<1, 1024>(p, l, A, BT, ntm, ntn, smem);
          else if (epi == 2) gemm_phase<2, 1024>(p, l, A, BT, ntm, ntn, smem);
          else if (epi == 3) gemm_phase<3, 1024>(p, l, A, BT, ntm, ntn, smem);
          else branch_phase(p, ntm, smem);
        }
      } else if (s == 4) {
        for (int rep = 0; rep < REP_ATT; ++rep) attn_phase(p, l, rep, smem);
      }
      else {
        const int rmode = s == 12 ? 0 : (s == 2 ? 1 : (s == 8 ? 2 : 3));
        rowpass(p, l, rmode);
        if (rmode == 0) { for (int rep = 1; rep < REP_ROW0; ++rep) rowpass(p, l, rmode); }
        if (rmode == 3 && l + 1 < 2) {
          for (int it = blockIdx.x; it < 1792; it += gridDim.x) convert_pair(p, l + 1, 4 * it, (float*)smem);
        }
      }
    }
    if (coop && ph + 1 < ph_hi) {
      if (ph == ph_lo) grid.sync();
      else { for (int rs = 0; rs < REP_SYNC; ++rs) xcd_barrier(xb); }
    }
  }
}

extern "C" void kernel_launch(void* const* d_in, const int* in_sizes, int n_in, void* d_out, int out_size, void* d_ws, size_t ws_size,
                              hipStream_t stream) {
  static int grid_blocks = 0;
  if (!grid_blocks) {
    int dev = 0, cus = 0, per_cu = 0;
    hipGetDevice(&dev);
    hipDeviceGetAttribute(&cus, hipDeviceAttributeMultiprocessorCount, dev);
    hipOccupancyMaxActiveBlocksPerMultiprocessor(&per_cu, mk_forward, 512, 0);
    if (per_cu > 1) per_cu = 1;
    if (per_cu < 1) per_cu = 1;
    grid_blocks = cus * per_cu;
    const size_t need = OFF_STASH + (size_t)grid_blocks * 131072;
    if (need > ws_size) fprintf(stderr, "workspace too small: need %zu have %zu\n", need, ws_size);
  }
  Params p{};
  p.x = (const float*)d_in[0]; p.c = (const float*)d_in[1]; p.ctx = (const float*)d_in[2]; p.c_ctx = (const float*)d_in[3];
  p.w_mod = (const float*)d_in[4]; p.b_mod = (const float*)d_in[5]; p.norm_gain = (const float*)d_in[6];
  p.wg = (const float*)d_in[7]; p.wu = (const float*)d_in[8]; p.wd = (const float*)d_in[9];
  p.w_in = (const float*)d_in[10]; p.w_branch = (const float*)d_in[11]; p.w_out = (const float*)d_in[12];
  p.diff_lambda = (const float*)d_in[13]; p.diff_subln = (const float*)d_in[14]; p.na_bias = (const float*)d_in[15];
  p.qk_norm = (const float*)d_in[16]; p.sink = (const float*)d_in[17];
  p.out = (float*)d_out; p.ws = (char*)d_ws;
  p.pad = 0;
  hipMemsetAsync((char*)d_ws + OFF_BAR, 0, 16384, stream);
#if MK_MULTI
  for (int ph = 0; ph < NPHASE; ++ph) {
    p.phase_lo = ph; p.phase_hi = ph + 1; p.coop = 0;
    hipLaunchKernelGGL(mk_forward, dim3(grid_blocks), dim3(512), 0, stream, p);
  }
#else
  p.phase_lo = 0; p.phase_hi = NPHASE; p.coop = 1;
  void* args[] = {&p};
  hipError_t e = hipLaunchCooperativeKernel((void*)mk_forward, dim3(grid_blocks), dim3(512), args, 0, stream);
  if (e != hipSuccess) fprintf(stderr, "cooperative launch failed: %s (grid %d)\n", hipGetErrorString(e), grid_blocks);
#endif
}
```
